# Optimizing an MI355X kernel written in HIP

```python
import jax, jax.numpy as jnp
from jax import lax
import numpy as np

D_MODEL = 2048
BATCH = 4
SEQ = 2048
DEPTH = 4

GRID_W = 64
CTX_LEN = 256
N_MIXERS = 2
N_A_LAYERS = (DEPTH + 1) // 2
N_B_LAYERS = DEPTH // 2
A_CHUNK = 128
A_GROUP_DIM = 128
A_GROUPS = D_MODEL // A_GROUP_DIM
HEAD_DIM = 64
N_Q_HEADS = D_MODEL // HEAD_DIM
KV_GROUP = 8
N_KV_HEADS = N_Q_HEADS // KV_GROUP
WINDOW = 128
ATT_BLOCK = 128
ROPE_THETA = 10000.0
FFN_HIDDEN = -(-(8 * D_MODEL // 3) // 256) * 256
N_MOD = 6
EPS = 1e-6
NEG_INF = -1e30

kernel_name = "hybrid_gmlp_swa_diffusion_trunk"


def rmsnorm(x, g):
    x32 = x.astype(jnp.float32)
    y = x32 * lax.rsqrt(jnp.mean(x32 * x32, axis=-1, keepdims=True) + EPS)
    return y.astype(x.dtype) * g


def layernorm(x, g):
    x32 = x.astype(jnp.float32)
    mu = jnp.mean(x32, axis=-1, keepdims=True)
    var = jnp.mean(jnp.square(x32 - mu), axis=-1, keepdims=True)
    return ((x32 - mu) * lax.rsqrt(var + EPS)).astype(x.dtype) * g


def adaln(h, shift, scale):
    return h * (1 + scale) + shift


def axial_rope_tables(seq_len, dtype):
    rows = seq_len // GRID_W
    row = jnp.repeat(jnp.arange(rows), GRID_W)
    col = jnp.tile(jnp.arange(GRID_W), rows)
    pos = jnp.stack([row, col], axis=-1).astype(jnp.float32)
    n_freq = HEAD_DIM // 4
    inv = ROPE_THETA ** (-jnp.arange(n_freq, dtype=jnp.float32) / n_freq)
    ang = pos[:, :, None] * inv
    return jnp.cos(ang).astype(dtype), jnp.sin(ang).astype(dtype)


def apply_axial_rope(x, cos, sin):
    shp = x.shape
    xr = x.reshape(shp[0], shp[1], -1, 2, 2, HEAD_DIM // 4)
    x1, x2 = xr[..., 0, :], xr[..., 1, :]
    c = cos[None, :, None]
    s = sin[None, :, None]
    out = jnp.stack([x1 * c - x2 * s, x2 * c + x1 * s], axis=-2)
    return out.reshape(shp)


def chunked_spatial_gating(h, w_in, v_g, w_s, b_s, w_out):
    B, L, _ = h.shape
    z = jax.nn.gelu(h @ w_in, approximate=False)
    u, v = jnp.split(z, 2, axis=-1)
    v = layernorm(v, v_g).reshape(B, L // A_CHUNK, A_CHUNK, A_GROUPS, A_GROUP_DIM)
    s = jnp.einsum('gpq,bnqgc->bnpgc', w_s, v) + b_s.T[:, :, None]
    return (u * s.reshape(B, L, D_MODEL)) @ w_out


def split_qkv(h, w_qkv):
    B, L, _ = h.shape
    q, k, v = jnp.split(h @ w_qkv, [N_Q_HEADS * HEAD_DIM, (N_Q_HEADS + N_KV_HEADS) * HEAD_DIM], axis=-1)
    return (q.reshape(B, L, N_KV_HEADS, KV_GROUP, HEAD_DIM),
            k.reshape(B, L, N_KV_HEADS, HEAD_DIM),
            v.reshape(B, L, N_KV_HEADS, HEAD_DIM))


def sink_softmax(logits, sink):
    sk = jnp.broadcast_to(sink.astype(jnp.float32)[None, :, :, None, None], logits.shape[:-1] + (1,))
    p = jax.nn.softmax(jnp.concatenate([logits, sk], axis=-1), axis=-1)
    return p[..., :-1]


def windowed_gqa(h_lat, h_ctx, w_qkv, sink, w_o, cos, sin, need_ctx):
    B, S, _ = h_lat.shape
    scale = HEAD_DIM ** -0.5
    sink = sink.reshape(N_KV_HEADS, KV_GROUP)
    q, k, v = split_qkv(h_lat, w_qkv)
    q = apply_axial_rope(q, cos, sin)
    k = apply_axial_rope(k, cos, sin)
    qc, kc, vc = split_qkv(h_ctx, w_qkv)
    n_ctx = kc.shape[1]
    nb = S // ATT_BLOCK
    band = 3 * ATT_BLOCK
    q_blocks = jnp.moveaxis(q.reshape(B, nb, ATT_BLOCK, N_KV_HEADS, KV_GROUP, HEAD_DIM), 1, 0)
    pad = ((0, 0), (ATT_BLOCK, ATT_BLOCK), (0, 0), (0, 0))
    k_pad = jnp.pad(k, pad)
    v_pad = jnp.pad(v, pad)
    qi = jnp.arange(ATT_BLOCK)[:, None]
    kj = jnp.arange(band)[None, :]

    def block(args):
        n, qb = args
        start = n * ATT_BLOCK
        kb = lax.dynamic_slice_in_dim(k_pad, start, band, axis=1)
        vb = lax.dynamic_slice_in_dim(v_pad, start, band, axis=1)
        kpos = start - ATT_BLOCK + kj
        qpos = start + qi
        valid = (kpos >= 0) & (kpos < S) & (jnp.abs(qpos - kpos) <= WINDOW)
        s_band = jnp.einsum('bqhgd,bkhd->bhgqk', qb, kb).astype(jnp.float32) * scale
        s_band = jnp.where(valid, s_band, NEG_INF)
        s_ctx = jnp.einsum('bqhgd,bkhd->bhgqk', qb, kc).astype(jnp.float32) * scale
        p = sink_softmax(jnp.concatenate([s_ctx, s_band], axis=-1), sink).astype(vb.dtype)
        return (jnp.einsum('bhgqk,bkhd->bqhgd', p[..., :n_ctx], vc)
                + jnp.einsum('bhgqk,bkhd->bqhgd', p[..., n_ctx:], vb))

    o = lax.map(block, (jnp.arange(nb), q_blocks))
    o_lat = jnp.moveaxis(o, 0, 1).reshape(B, S, D_MODEL) @ w_o
    o_ctx = None
    if need_ctx:
        s = jnp.einsum('bqhgd,bkhd->bhgqk', qc, kc).astype(jnp.float32) * scale
        p = sink_softmax(s, sink).astype(vc.dtype)
        o_ctx = jnp.einsum('bhgqk,bkhd->bqhgd', p, vc).reshape(B, n_ctx, D_MODEL) @ w_o
    return o_lat, o_ctx


def swiglu(h, w_gu, w_down):
    g, u = jnp.split(h @ w_gu, 2, axis=-1)
    return (jax.nn.silu(g) * u) @ w_down


def setup_inputs(seed: int = 0) -> dict:
    key = jax.random.key(seed)
    ks = jax.random.split(key, 18)
    f32 = jnp.float32
    D = D_MODEL
    nrm = lambda k, shape, fan_in: jax.random.normal(k, shape, f32) * (fan_in ** -0.5)
    return {
        "x": jax.random.normal(ks[0], (BATCH, SEQ, D), f32),
        "c": jax.random.normal(ks[1], (BATCH, D), f32),
        "ctx": jax.random.normal(ks[2], (BATCH, CTX_LEN, D), f32),
        "c_ctx": jax.random.normal(ks[3], (D,), f32),
        "w_mod": nrm(ks[4], (DEPTH, D, N_MOD * D), D),
        "b_mod": 0.02 * jax.random.normal(ks[5], (DEPTH, N_MOD * D), f32),
        "norm_g": 1.0 + 0.05 * jax.random.normal(ks[6], (DEPTH, 4, D), f32),
        "a_w_in": nrm(ks[7], (N_A_LAYERS, D, 2 * D), D),
        "a_v_norm_g": 1.0 + 0.05 * jax.random.normal(ks[8], (N_A_LAYERS, D), f32),
        "a_w_s": nrm(ks[9], (N_A_LAYERS, A_GROUPS, A_CHUNK, A_CHUNK), A_CHUNK),
        "a_b_s": 1.0 + 0.05 * jax.random.normal(ks[10], (N_A_LAYERS, A_GROUPS, A_CHUNK), f32),
        "a_w_out": nrm(ks[11], (N_A_LAYERS, D, D), D),
        "b_w_qkv": nrm(ks[12], (N_B_LAYERS, D, (N_Q_HEADS + 2 * N_KV_HEADS) * HEAD_DIM), D),
        "b_sink": jax.random.normal(ks[13], (N_B_LAYERS, N_Q_HEADS), f32),
        "b_w_o": nrm(ks[14], (N_B_LAYERS, N_Q_HEADS * HEAD_DIM, D), N_Q_HEADS * HEAD_DIM),
        "f_w_gu": nrm(ks[15], (DEPTH, D, 2 * FFN_HIDDEN), D),
        "f_w_down": nrm(ks[16], (DEPTH, FFN_HIDDEN, D), FFN_HIDDEN),
    }


def reference(x, c, ctx, c_ctx, w_mod, b_mod, norm_g, a_w_in, a_v_norm_g, a_w_s, a_b_s, a_w_out,
              b_w_qkv, b_sink, b_w_o, f_w_gu, f_w_down):
    B, S, _ = x.shape
    cos, sin = axial_rope_tables(S, x.dtype)
    silu_c = jax.nn.silu(c)
    silu_cc = jax.nn.silu(c_ctx)
    for i in range(DEPTH):
        last = i == DEPTH - 1
        is_attn = (i % N_MIXERS) == 1
        j = i // N_MIXERS
        need_ctx_in = is_attn or not last
        mod = (silu_c @ w_mod[i] + b_mod[i]).reshape(B, N_MOD, 1, D_MODEL)
        sh_m, sc_m, g_m, sh_f, sc_f, g_f = (mod[:, t] for t in range(N_MOD))
        h_lat = adaln(rmsnorm(x, norm_g[i, 0]), sh_m, sc_m)
        if need_ctx_in:
            mod_c = (silu_cc @ w_mod[i] + b_mod[i]).reshape(N_MOD, D_MODEL)
            h_ctx = adaln(rmsnorm(ctx, norm_g[i, 0]), mod_c[0], mod_c[1])
        if is_attn:
            y_lat, y_ctx = windowed_gqa(h_lat, h_ctx, b_w_qkv[j], b_sink[j], b_w_o[j], cos, sin,
                                        need_ctx=not last)
        else:
            y_lat = chunked_spatial_gating(h_lat, a_w_in[j], a_v_norm_g[j], a_w_s[j], a_b_s[j], a_w_out[j])
            y_ctx = None
            if not last:
                y_ctx = chunked_spatial_gating(h_ctx, a_w_in[j], a_v_norm_g[j], a_w_s[j], a_b_s[j], a_w_out[j])
        x = x + g_m * rmsnorm(y_lat, norm_g[i, 1])
        if not last:
            ctx = ctx + mod_c[2] * rmsnorm(y_ctx, norm_g[i, 1])
        f_lat = swiglu(adaln(rmsnorm(x, norm_g[i, 2]), sh_f, sc_f), f_w_gu[i], f_w_down[i])
        x = x + g_f * rmsnorm(f_lat, norm_g[i, 3])
        if not last:
            f_ctx = swiglu(adaln(rmsnorm(ctx, norm_g[i, 2]), mod_c[3], mod_c[4]), f_w_gu[i], f_w_down[i])
            ctx = ctx + mod_c[5] * rmsnorm(f_ctx, norm_g[i, 3])
    return x
```

```cpp
#include <hip/hip_runtime.h>
#include <cstdio>
#include <cstdint>

constexpr int D = 2048, NB = 4, SEQ = 2048, CTXL = 256, DEPTH = 4;
constexpr int RL = NB * SEQ;
constexpr int RC = NB * CTXL;
constexpr int R = RL + RC;
constexpr int FF = 5632, NMOD = 6, NQKV = 2560, NH = 32, NKV = 4, HD = 64;
constexpr float EPS = 1e-6f;

__device__ __forceinline__ int mod_index(int row) { return row < RL ? (row >> 11) : 4; }

__global__ void k_mod(const float* __restrict__ c, const float* __restrict__ c_ctx, const float* __restrict__ w_mod, const float* __restrict__ b_mod, float* __restrict__ modv) {
    const int idx = blockIdx.x * 256 + threadIdx.x;
    const int n = idx % (NMOD * D), r = (idx / (NMOD * D)) % 5, l = idx / (NMOD * D * 5);
    const float* cv = r < 4 ? c + r * D : c_ctx;
    const float* w = w_mod + (size_t)l * D * (NMOD * D) + n;
    float acc = 0.f;
    for (int k = 0; k < D; ++k) { const float cc = cv[k]; const float s = cc / (1.f + expf(-cc)); acc += s * w[(size_t)k * (NMOD * D)]; }
    modv[idx] = acc + b_mod[l * (NMOD * D) + n];
}

__device__ __forceinline__ float block_sum256(float v, float* red) {
    for (int o = 32; o > 0; o >>= 1) v += __shfl_xor(v, o);
    __syncthreads();
    if ((threadIdx.x & 63) == 0) red[threadIdx.x >> 6] = v;
    __syncthreads();
    return red[0] + red[1] + red[2] + red[3];
}

__global__ void k_norm(const float* __restrict__ xs, const float* __restrict__ g, const float* __restrict__ modl  , int sh_t, int sc_t, float* __restrict__ h) {
    __shared__ float red[4];
    const int row = blockIdx.x; const float* x = xs + (size_t)row * D;
    float v[8]; float ss = 0.f;
#pragma unroll
    for (int i = 0; i < 8; ++i) { v[i] = x[threadIdx.x + 256 * i]; ss += v[i] * v[i]; }
    ss = block_sum256(ss, red);
    const float rs = rsqrtf(ss * (1.f / D) + EPS);
    const float* m = modl + mod_index(row) * (NMOD * D);
#pragma unroll
    for (int i = 0; i < 8; ++i) { const int cidx = threadIdx.x + 256 * i; h[(size_t)row * D + cidx] = (v[i] * rs * g[cidx]) * (1.f + m[sc_t * D + cidx]) + m[sh_t * D + cidx]; }
}

__global__ void k_resid(const float* xin, const float* __restrict__ y, const float* __restrict__ g, const float* __restrict__ modl, int gate_t, float* xout) {
    __shared__ float red[4];
    const int row = blockIdx.x; const float* yr = y + (size_t)row * D;
    float v[8]; float ss = 0.f;
#pragma unroll
    for (int i = 0; i < 8; ++i) { v[i] = yr[threadIdx.x + 256 * i]; ss += v[i] * v[i]; }
    ss = block_sum256(ss, red);
    const float rs = rsqrtf(ss * (1.f / D) + EPS);
    const float* m = modl + mod_index(row) * (NMOD * D);
#pragma unroll
    for (int i = 0; i < 8; ++i) { const int cidx = threadIdx.x + 256 * i; xout[(size_t)row * D + cidx] = xin[(size_t)row * D + cidx] + m[gate_t * D + cidx] * (v[i] * rs * g[cidx]); }
}

template <int EPI>
__global__ void k_gemm(const float* __restrict__ A, const float* __restrict__ W, float* __restrict__ C, int M, int N, int K, int ldw, int ldc) {
    __shared__ float As[16][64 + 4];
    __shared__ float Bs[16][64 + 4];
    __shared__ float B2[EPI == 2 ? 16 : 1][64 + 4];
    const int tx = threadIdx.x & 15, ty = threadIdx.x >> 4;
    const int m0 = blockIdx.y * 64, n0 = blockIdx.x * 64;
    float acc[4][4] = {}, acc2[4][4] = {};
    for (int k0 = 0; k0 < K; k0 += 16) {
#pragma unroll
        for (int i = 0; i < 4; ++i) { const int e = threadIdx.x + 256 * i; const int r = e >> 4, kk = e & 15; As[kk][r] = A[(size_t)(m0 + r) * K + k0 + kk]; }
#pragma unroll
        for (int i = 0; i < 4; ++i) { const int e = threadIdx.x + 256 * i; const int kk = e >> 6, cn = e & 63; Bs[kk][cn] = W[(size_t)(k0 + kk) * ldw + n0 + cn];
            if (EPI == 2) B2[kk][cn] = W[(size_t)(k0 + kk) * ldw + n0 + cn + FF]; }
        __syncthreads();
#pragma unroll
        for (int kk = 0; kk < 16; ++kk) {
            float a[4], b[4], b2[4];
#pragma unroll
            for (int i = 0; i < 4; ++i) { a[i] = As[kk][ty * 4 + i]; b[i] = Bs[kk][tx * 4 + i]; if (EPI == 2) b2[i] = B2[kk][tx * 4 + i]; }
#pragma unroll
            for (int i = 0; i < 4; ++i)
#pragma unroll
                for (int j = 0; j < 4; ++j) { acc[i][j] += a[i] * b[j]; if (EPI == 2) acc2[i][j] += a[i] * b2[j]; }
        }
        __syncthreads();
    }
#pragma unroll
    for (int i = 0; i < 4; ++i)
#pragma unroll
        for (int j = 0; j < 4; ++j) {
            const int row = m0 + ty * 4 + i, col = n0 + tx * 4 + j; float v = acc[i][j];
            if (EPI == 1) v = 0.5f * v * (1.f + erff(v * 0.70710678118654752f));
            if (EPI == 2) v = (v / (1.f + expf(-v))) * acc2[i][j];
            C[(size_t)row * ldc + col] = v;
        }
}

__global__ void k_lnstats(const float* __restrict__ uv, float* __restrict__ stats) {
    __shared__ float red[4];
    const int row = blockIdx.x; const float* v = uv + (size_t)row * (2 * D) + D;
    float x[8]; float s = 0.f;
#pragma unroll
    for (int i = 0; i < 8; ++i) { x[i] = v[threadIdx.x + 256 * i]; s += x[i]; }
    s = block_sum256(s, red);
    const float mu = s * (1.f / D); float q = 0.f;
#pragma unroll
    for (int i = 0; i < 8; ++i) { const float d = x[i] - mu; q += d * d; }
    q = block_sum256(q, red);
    if (threadIdx.x == 0) { stats[2 * row] = mu; stats[2 * row + 1] = rsqrtf(q * (1.f / D) + EPS); }
}
__global__ void k_sg(const float* __restrict__ uv, const float* __restrict__ stats, const float* __restrict__ vg, const float* __restrict__ w_s  , const float* __restrict__ b_s  , float* __restrict__ T) {
    const int row = blockIdx.x; const int chunk = row >> 7, p = row & 127;
    for (int ch = threadIdx.x; ch < D; ch += 256) {
        const int g = ch >> 7; const float* ws = w_s + ((size_t)g * 128 + p) * 128; float acc = 0.f;
        for (int q = 0; q < 128; ++q) { const int r2 = chunk * 128 + q; const float vv = (uv[(size_t)r2 * (2 * D) + D + ch] - stats[2 * r2]) * stats[2 * r2 + 1]; acc += ws[q] * vv; }
        acc = acc * vg[ch] + b_s[g * 128 + p];
        T[(size_t)row * D + ch] = uv[(size_t)row * (2 * D) + ch] * acc;
    }
}

__global__ void k_rope(float* __restrict__ qkv) {
    const size_t idx = (size_t)blockIdx.x * 256 + threadIdx.x;
    const int pr = idx & 31, hh = (idx >> 5) % 36, row = idx / (32 * 36);
    const int a = pr >> 4, f = pr & 15;
    const int s = row & (SEQ - 1); const float pos = a == 0 ? (float)(s >> 6) : (float)(s & 63);
    const float inv = powf(10000.f, -(float)f / 16.f); const float ang = pos * inv;
    const float cs = cosf(ang), sn = sinf(ang);
    float* base = qkv + (size_t)row * NQKV + hh * 64 + a * 32 + f;
    const float x1 = base[0], x2 = base[16];
    base[0] = x1 * cs - x2 * sn; base[16] = x2 * cs + x1 * sn;
}
__global__ void __launch_bounds__(64) k_attn(const float* __restrict__ qkv, const float* __restrict__ sink, float* __restrict__ O, int nrows) {
    const int idx = blockIdx.x * 64 + threadIdx.x; const int row = idx >> 5, hq = idx & 31; if (row >= nrows) return;
    const int kvh = hq >> 3;
    float q[64], o[64];
    const float* qp = qkv + (size_t)row * NQKV + hq * 64;
#pragma unroll
    for (int d = 0; d < 64; ++d) { q[d] = qp[d] * 0.125f; o[d] = 0.f; }
    float m = sink[hq], l = 1.f;
    int b, k_lo, k_hi;
    if (row < RL) { b = row >> 11; const int s = row & (SEQ - 1); k_lo = s - 128 < 0 ? 0 : s - 128; k_hi = s + 128 > SEQ - 1 ? SEQ - 1 : s + 128; } else { b = (row - RL) >> 8; k_lo = 0; k_hi = -1; }
    const int nlat = k_hi - k_lo + 1;
    for (int j = 0; j < CTXL + nlat; ++j) {
        const int krow = j < CTXL ? RL + b * CTXL + j : b * SEQ + k_lo + (j - CTXL);
        const float* kp = qkv + (size_t)krow * NQKV + 2048 + kvh * 64; const float* vp = kp + 256;
        float sc = 0.f;
#pragma unroll
        for (int d = 0; d < 64; ++d) sc += q[d] * kp[d];
        const float mn = fmaxf(m, sc), corr = expf(m - mn), pp = expf(sc - mn);
        l = l * corr + pp; m = mn;
#pragma unroll
        for (int d = 0; d < 64; ++d) o[d] = o[d] * corr + pp * vp[d];
    }
    const float il = 1.f / l; float* op = O + (size_t)row * D + hq * 64;
#pragma unroll
    for (int d = 0; d < 64; ++d) op[d] = o[d] * il;
}

__global__ void k_concat(const float* __restrict__ x, const float* __restrict__ ctx, float* __restrict__ xs) {
    const size_t i = (size_t)blockIdx.x * 256 + threadIdx.x;
    const size_t nl = (size_t)RL * D / 4;
    ((float4*)xs)[i] = i < nl ? ((const float4*)x)[i] : ((const float4*)ctx)[i - nl];
}

extern "C" void kernel_launch(void* const* d_in, const int* in_sizes, int n_in, void* d_out, int out_size, void* d_ws, size_t ws_size, hipStream_t stream) {
    const float* x = (const float*)d_in[0]; const float* c = (const float*)d_in[1]; const float* ctx = (const float*)d_in[2]; const float* c_ctx = (const float*)d_in[3];
    const float* w_mod = (const float*)d_in[4]; const float* b_mod = (const float*)d_in[5]; const float* norm_g = (const float*)d_in[6];
    const float* a_w_in = (const float*)d_in[7]; const float* a_vg = (const float*)d_in[8]; const float* a_w_s = (const float*)d_in[9]; const float* a_b_s = (const float*)d_in[10];
    const float* a_w_out = (const float*)d_in[11]; const float* b_w_qkv = (const float*)d_in[12]; const float* b_sink = (const float*)d_in[13]; const float* b_w_o = (const float*)d_in[14];
    const float* f_w_gu = (const float*)d_in[15]; const float* f_w_down = (const float*)d_in[16];
    float* out = (float*)d_out;
    char* ws = (char*)d_ws; size_t off = 0;
    auto carve = [&](size_t bytes) { char* p = ws + off; off += (bytes + 255) & ~(size_t)255; return (float*)p; };
    float* MODV = carve((size_t)DEPTH * 5 * NMOD * D * 4);
    float* XS = carve((size_t)R * D * 4);
    float* H = carve((size_t)R * D * 4);
    float* UV = carve((size_t)R * 2 * D * 4);
    float* T = carve((size_t)R * D * 4);
    float* Y = carve((size_t)R * D * 4);
    float* ACT = carve((size_t)R * FF * 4);
    float* STATS = carve((size_t)R * 2 * 4);
    if (off > ws_size) { fprintf(stderr, "ws too small: need %zu have %zu\n", off, ws_size); return; }

    k_mod<<<DEPTH * 5 * NMOD * D / 256, 256, 0, stream>>>(c, c_ctx, w_mod, b_mod, MODV);
    k_concat<<<(size_t)R * D / 4 / 256, 256, 0, stream>>>(x, ctx, XS);
    for (int i = 0; i < DEPTH; ++i) {
        const bool last = i == DEPTH - 1, is_attn = (i & 1) == 1; const int j = i >> 1;
        const float* modl = MODV + (size_t)i * 5 * NMOD * D; const float* ng = norm_g + (size_t)i * 4 * D;
        const int Mact = last ? RL : R;
        k_norm<<<R, 256, 0, stream>>>(XS, ng + 0 * D, modl, 0, 1, H);
        if (!is_attn) {
            k_gemm<1><<<dim3(2 * D / 64, R / 64), 256, 0, stream>>>(H, a_w_in + (size_t)j * D * 2 * D, UV, R, 2 * D, D, 2 * D, 2 * D);
            k_lnstats<<<R, 256, 0, stream>>>(UV, STATS);
            k_sg<<<R, 256, 0, stream>>>(UV, STATS, a_vg + j * D, a_w_s + (size_t)j * 16 * 128 * 128, a_b_s + j * 16 * 128, T);
            k_gemm<0><<<dim3(D / 64, R / 64), 256, 0, stream>>>(T, a_w_out + (size_t)j * D * D, Y, R, D, D, D, D);
        } else {
            k_gemm<0><<<dim3(NQKV / 64, R / 64), 256, 0, stream>>>(H, b_w_qkv + (size_t)j * D * NQKV, UV, R, NQKV, D, NQKV, NQKV);
            k_rope<<<(size_t)RL * 36 * 32 / 256, 256, 0, stream>>>(UV);
            k_attn<<<Mact * 32 / 64, 64, 0, stream>>>(UV, b_sink + j * 32, T, Mact);
            k_gemm<0><<<dim3(D / 64, Mact / 64), 256, 0, stream>>>(T, b_w_o + (size_t)j * D * D, Y, Mact, D, D, D, D);
        }
        k_resid<<<Mact, 256, 0, stream>>>(XS, Y, ng + 1 * D, modl, 2, XS);
        k_norm<<<Mact, 256, 0, stream>>>(XS, ng + 2 * D, modl, 3, 4, H);
        k_gemm<2><<<dim3(FF / 64, Mact / 64), 256, 0, stream>>>(H, f_w_gu + (size_t)i * D * 2 * FF, ACT, Mact, FF, D, 2 * FF, FF);
        k_gemm<0><<<dim3(D / 64, Mact / 64), 256, 0, stream>>>(ACT, f_w_down + (size_t)i * FF * D, Y, Mact, D, FF, D, D);
        k_resid<<<Mact, 256, 0, stream>>>(XS, Y, ng + 3 * D, modl, 5, last ? out : XS);
    }
}
```

```cpp
#include <hip/hip_runtime.h>
#include <cstdio>
#include <cstdint>

constexpr int D = 2048, NB = 4, SEQ = 2048, CTXL = 256, DEPTH = 4;
constexpr int RL = NB * SEQ;
constexpr int RC = NB * CTXL;
constexpr int R = RL + RC;
constexpr int FF = 5632, NMOD = 6, NQKV = 2560;
constexpr float EPS = 1e-6f;
constexpr float LOG2E = 1.4426950408889634f;
#define DEBUG_TRUTH_ONLY 0
#define DEBUG_PH_LO 0
#define DEBUG_PH_HI 99
#ifndef DEBUG_CHECK
#define DEBUG_CHECK 0
#endif
namespace pg8 {
#define PG8_LAS __attribute__((address_space(3)))
typedef unsigned short bf16_t;
typedef short bf16x8 __attribute__((ext_vector_type(8)));
typedef float f32x4 __attribute__((ext_vector_type(4)));
typedef unsigned u32x4 __attribute__((ext_vector_type(4)));
constexpr int BM = 256, BK = 64, HALF = 128, HTB = HALF * BK * 2  , STAGE_BYTES = 8 * HTB, NXCD = 8, WGM = 8;

__host__ __device__ __forceinline__ int lds_byte(int r, int c) { const int st = (r >> 4) * 2 + (c >> 5), rr = r & 15, cc = c & 31, ob = rr * 64 + cc * 2; return st * 1024 + (ob ^ (((ob >> 9) & 1) << 5)); }
__host__ __device__ __forceinline__ void stage_rc(int b, int& R, int& C) { const int st = b / 1024, sb = b % 1024, swz = sb ^ (((sb >> 9) & 1) << 5); R = (st >> 1) * 16 + swz / 64; C = (st & 1) * 32 + (swz % 64) / 2; }
__host__ __device__ __forceinline__ int perm32(int rho) { const int n = rho >> 4, i = rho & 15; return 8 * (i >> 2) + 4 * n + (i & 3); }

struct Unit { int pm, pn; };
struct Gemm { const bf16_t* A; const bf16_t* Bt; int M, N, K; };

struct StaticOrder {
    int nM, nN, nwg, G, c;
    __host__ __device__ void init(int M, int N, int G_, int c_) { nM = M / BM; nN = N / BM; nwg = nM * nN; G = G_; c = c_; }
    __host__ __device__ bool next(int i, Unit& u) const {
        const long L = (long)i * G + c; if (L >= nwg) return false;
        int wgid = (int)L; { const int q = nwg / NXCD, r = nwg % NXCD, xcd = wgid % NXCD, off = wgid / NXCD; wgid = (xcd < r ? xcd * (q + 1) : r * (q + 1) + (xcd - r) * q) + off; }
        const int nig = WGM * nN, gid = wgid / nig, fm = gid * WGM, gsz = (nM - fm) < WGM ? (nM - fm) : WGM;
        u.pm = fm + ((wgid % nig) % gsz); u.pn = (wgid % nig) / gsz; return true;
    }
    __device__ __forceinline__ void a_ready(const Unit&) const {}
    __device__ __forceinline__ void done(const Unit&) const {}
};

__device__ __forceinline__ unsigned cvt_pk_bf16(float lo, float hi) { unsigned r; asm volatile("v_cvt_pk_bf16_f32 %0, %1, %2" : "=v"(r) : "v"(lo), "v"(hi)); return r; }
typedef float f32x2 __attribute__((ext_vector_type(2)));
__device__ __forceinline__ f32x2 gelu_pk(f32x2 v) {
    const f32x2 av = __builtin_elementwise_abs(v), d = av * 0.2316418882f + 1.0f;
    f32x2 t; t.x = __builtin_amdgcn_rcpf(d.x); t.y = __builtin_amdgcn_rcpf(d.y);
    f32x2 q = t * 0.5307027145f + (-0.7265760135f); q = q * t + 0.7107068705f; q = q * t + (-0.142248368f); q = q * t + 0.127414796f; q = q * t;
    const f32x2 s = (v * v) * (-0.72134752044f);
    f32x2 e; e.x = __builtin_amdgcn_exp2f(s.x); e.y = __builtin_amdgcn_exp2f(s.y);
    const f32x2 m = v * (q * e), r = v - m;
    f32x2 o; o.x = v.x < 0.f ? m.x : r.x; o.y = v.y < 0.f ? m.y : r.y; return o;
}

typedef float f32x2e __attribute__((ext_vector_type(2)));
struct EpiGeluStats {
    static constexpr bool PERM = true, AFTER_DRAIN = false;
    bf16_t* O; float* stats;
    __device__ __forceinline__ void operator()(const f32x4 (&acc)[2][2][4][2], const Unit& u, int wr, int wc, int fr, int fq) const {
        const int row0 = u.pm * BM + wr * 64 + fr, col0 = u.pn * BM + wc * 32 + 8 * fq;
        const bool vhalf = u.pn >= 8;
#pragma unroll
        for (int ai = 0; ai < 2; ++ai)
#pragma unroll
            for (int m = 0; m < 4; ++m) {
                const int row = row0 + ai * HALF + m * 16; bf16_t* rowp = O + (size_t)row * 4096 + col0; float s1 = 0.f, s2 = 0.f;
#pragma unroll
                for (int bj = 0; bj < 2; ++bj) {
                    const f32x4 v0 = acc[ai][bj][m][0], v1 = acc[ai][bj][m][1];
                    const f32x2 a = gelu_pk((f32x2){v0[0], v0[1]}), b = gelu_pk((f32x2){v0[2], v0[3]}), c = gelu_pk((f32x2){v1[0], v1[1]}), d = gelu_pk((f32x2){v1[2], v1[3]});
                    s1 += ((a.x + a.y) + (b.x + b.y)) + ((c.x + c.y) + (d.x + d.y));
                    s2 += ((a.x * a.x + a.y * a.y) + (b.x * b.x + b.y * b.y)) + ((c.x * c.x + c.y * c.y) + (d.x * d.x + d.y * d.y));
                    u32x4 w; w.x = cvt_pk_bf16(a.x, a.y); w.y = cvt_pk_bf16(b.x, b.y); w.z = cvt_pk_bf16(c.x, c.y); w.w = cvt_pk_bf16(d.x, d.y);
                    *(u32x4*)(rowp + bj * HALF) = w;
                }
                if (vhalf) {
                    s1 += __shfl_xor(s1, 16); s2 += __shfl_xor(s2, 16); s1 += __shfl_xor(s1, 32); s2 += __shfl_xor(s2, 32);
                    if (fq == 0) { f32x2e o; o.x = s1; o.y = s2; *(f32x2e*)(stats + ((size_t)row * 32 + (u.pn - 8) * 4 + wc) * 2) = o; }
                }
            }
    }
};
struct EpiF32 {
    static constexpr bool PERM = true, AFTER_DRAIN = false;
    float* O; int ldc;
    __device__ __forceinline__ void operator()(const f32x4 (&acc)[2][2][4][2], const Unit& u, int wr, int wc, int fr, int fq) const {
        const int row0 = u.pm * BM + wr * 64 + fr, col0 = u.pn * BM + wc * 32 + 8 * fq;
#pragma unroll
        for (int ai = 0; ai < 2; ++ai)
#pragma unroll
            for (int m = 0; m < 4; ++m) { float* rowp = O + (size_t)(row0 + ai * HALF + m * 16) * ldc + col0;
#pragma unroll
                for (int bj = 0; bj < 2; ++bj) { *(f32x4*)(rowp + bj * HALF) = acc[ai][bj][m][0]; *(f32x4*)(rowp + bj * HALF + 4) = acc[ai][bj][m][1]; } }
    }
};
__device__ __forceinline__ float silu_mul(float g, float u) { return g * __builtin_amdgcn_rcpf(1.f + __builtin_amdgcn_exp2f(-1.4426950408889634f * g)) * u; }
struct EpiSwiGLU {
    static constexpr bool PERM = true, AFTER_DRAIN = false;
    bf16_t* O;
    __device__ __forceinline__ void operator()(const f32x4 (&acc)[2][2][4][2], const Unit& u, int wr, int wc, int fr, int fq) const {
        const int row0 = u.pm * BM + wr * 64 + fr, col0 = u.pn * HALF + wc * 32 + 8 * fq;
#pragma unroll
        for (int ai = 0; ai < 2; ++ai)
#pragma unroll
            for (int m = 0; m < 4; ++m) {
                const f32x4 g0 = acc[ai][0][m][0], g1 = acc[ai][0][m][1], u0 = acc[ai][1][m][0], u1 = acc[ai][1][m][1];
                u32x4 w; w.x = cvt_pk_bf16(silu_mul(g0[0], u0[0]), silu_mul(g0[1], u0[1])); w.y = cvt_pk_bf16(silu_mul(g0[2], u0[2]), silu_mul(g0[3], u0[3]));
                w.z = cvt_pk_bf16(silu_mul(g1[0], u1[0]), silu_mul(g1[1], u1[1])); w.w = cvt_pk_bf16(silu_mul(g1[2], u1[2]), silu_mul(g1[3], u1[3]));
                *(u32x4*)(O + (size_t)(row0 + ai * HALF + m * 16) * 5632 + col0) = w;
            }
    }
};
struct EpiQKV {
    static constexpr bool PERM = true, AFTER_DRAIN = false;
    bf16_t* O; const float* rc; const float* rs; float qscale;
    __device__ __forceinline__ void operator()(const f32x4 (&acc)[2][2][4][2], const Unit& u, int wr, int wc, int fr, int fq) const {
        const int row0 = u.pm * BM + wr * 64 + fr, col0 = u.pn * BM + wc * 32 + 8 * fq;
        const bool rope = (u.pm < 32) && (u.pn < 9); const float sc = u.pn < 8 ? qscale : 1.f;
        const int axis = wc & 1, f0 = 8 * (fq & 1); const float sgn = fq < 2 ? -1.f : 1.f;
#pragma unroll
        for (int ai = 0; ai < 2; ++ai)
#pragma unroll
            for (int m = 0; m < 4; ++m) {
                const int row = row0 + ai * HALF + m * 16; bf16_t* rowp = O + (size_t)row * 2560 + col0;
                f32x4 cs[2], sn[2];
                if (rope) { const int s = row & 2047; const int pos = axis ? (s & 63) : (s >> 6);
                    cs[0] = *(const f32x4*)(rc + pos * 16 + f0); cs[1] = *(const f32x4*)(rc + pos * 16 + f0 + 4); sn[0] = *(const f32x4*)(rs + pos * 16 + f0); sn[1] = *(const f32x4*)(rs + pos * 16 + f0 + 4); }
#pragma unroll
                for (int bj = 0; bj < 2; ++bj) {
                    f32x4 v[2] = {acc[ai][bj][m][0], acc[ai][bj][m][1]};
                    if (rope) {
#pragma unroll
                        for (int n = 0; n < 2; ++n)
#pragma unroll
                            for (int e = 0; e < 4; ++e) { const float p = __shfl_xor(v[n][e], 32); v[n][e] = v[n][e] * cs[n][e] + sgn * p * sn[n][e]; }
                    }
                    v[0] = v[0] * sc; v[1] = v[1] * sc;
                    u32x4 w; w.x = cvt_pk_bf16(v[0][0], v[0][1]); w.y = cvt_pk_bf16(v[0][2], v[0][3]); w.z = cvt_pk_bf16(v[1][0], v[1][1]); w.w = cvt_pk_bf16(v[1][2], v[1][3]);
                    *(u32x4*)(rowp + bj * HALF) = w;
                }
            }
    }
};
template <class Epi, class Sched, bool ALIGN_EPI = false, bool SP2 = false>
__device__ __forceinline__ void gemm_phase(PG8_LAS unsigned char* lds, const Gemm g, const Sched& S, const Epi& E) {
    const int tid = threadIdx.x, wid = __builtin_amdgcn_readfirstlane(tid >> 6), lane = tid & 63, wr = wid >> 2, wc = wid & 3, fr = lane & 15, fq = lane >> 4;
    const int K = g.K, nt = K / BK;
    unsigned voffA[2], voffB[2];
#pragma unroll
    for (int i = 0; i < 2; ++i) { int R, C; stage_rc(tid * 16 + i * 8192, R, C); const int Rb = Epi::PERM ? ((R & ~31) + perm32(R & 31)) : R;
        voffA[i] = (unsigned)(R * K + C) * 2u; voffB[i] = (unsigned)(Rb * K + C) * 2u; }
    const size_t kstep = (size_t)(BK * 2);
    const size_t hstep = (size_t)HALF * K * 2;
    const size_t tstep = 2 * hstep;
    const unsigned ldsw = (unsigned)wid * 1024u;
    const int aoff = lds_byte(wr * 64 + fr, fq * 8), boff = lds_byte(wc * 32 + fr, fq * 8);
#define PG8_SA(b, h) (((b) * 2 + (h)) * HTB)
#define PG8_SB(b, h) ((4 + (b) * 2 + (h)) * HTB)
#define PG8_STAGE(bufoff, gbase, voff) do { _Pragma("unroll") for (int _i = 0; _i < 2; ++_i) \
        __builtin_amdgcn_global_load_lds((const unsigned*)((const char*)(gbase) + (voff)[_i]), (PG8_LAS unsigned*)(lds + (bufoff) + ldsw + _i * 8192), 16, 0, 0); } while (0)
#define PG8_LDA(dst, b, h) do { _Pragma("unroll") for (int m = 0; m < 4; ++m) _Pragma("unroll") for (int k = 0; k < 2; ++k) dst[m][k] = *(const PG8_LAS bf16x8*)(lds + PG8_SA(b, h) + aoff + m * 2048 + k * 1024); } while (0)
#define PG8_LDB(dst, b, h) do { _Pragma("unroll") for (int n = 0; n < 2; ++n) _Pragma("unroll") for (int k = 0; k < 2; ++k) dst[n][k] = *(const PG8_LAS bf16x8*)(lds + PG8_SB(b, h) + boff + n * 2048 + k * 1024); } while (0)
#define PG8_MMA(ai, bj, At, Bt) do { __builtin_amdgcn_s_setprio(1); _Pragma("unroll") for (int m = 0; m < 4; ++m) _Pragma("unroll") for (int n = 0; n < 2; ++n) _Pragma("unroll") for (int k = 0; k < 2; ++k) \
        acc[ai][bj][m][n] = __builtin_amdgcn_mfma_f32_16x16x32_bf16(Bt[n][k], At[m][k], acc[ai][bj][m][n], 0, 0, 0); __builtin_amdgcn_s_setprio(0); } while (0)
#define PG8_WAIT_V(n) asm volatile("s_waitcnt vmcnt(" #n ")" ::: "memory")
#define PG8_WAIT_L(n) asm volatile("s_waitcnt lgkmcnt(" #n ")" ::: "memory")
#define PG8_BAR __builtin_amdgcn_s_barrier()
#define PG8_SCHED __builtin_amdgcn_sched_barrier(0)
    Unit cur, nxt; int ui = 0;
    if (!S.next(0, cur)) return;
    f32x4 acc[2][2][4][2];
#pragma unroll
    for (int a = 0; a < 2; ++a)
#pragma unroll
        for (int b = 0; b < 2; ++b)
#pragma unroll
            for (int m = 0; m < 4; ++m)
#pragma unroll
                for (int n = 0; n < 2; ++n) acc[a][b][m][n] = (f32x4){0.f, 0.f, 0.f, 0.f};
    bf16x8 At[4][2], B0[2][2], B1[2][2];
    const char* cA = (const char*)g.A + (size_t)cur.pm * tstep; const char* cB = (const char*)g.Bt + (size_t)cur.pn * tstep;
    S.a_ready(cur);
    if constexpr (SP2) {
        PG8_STAGE(PG8_SB(0, 0), cB, voffB); PG8_STAGE(PG8_SB(0, 1), cB + hstep, voffB); PG8_STAGE(PG8_SA(0, 0), cA, voffA); PG8_STAGE(PG8_SA(0, 1), cA + hstep, voffA);
        if (wr == 1) PG8_BAR;
        PG8_WAIT_V(2); PG8_BAR;
        PG8_STAGE(PG8_SB(1, 0), cB + kstep, voffB); PG8_STAGE(PG8_SA(1, 0), cA + kstep, voffA); PG8_STAGE(PG8_SB(1, 1), cB + hstep + kstep, voffB);
        PG8_WAIT_V(6); PG8_BAR;
    } else {
        PG8_STAGE(PG8_SB(0, 0), cB, voffB); PG8_STAGE(PG8_SA(0, 0), cA, voffA); PG8_STAGE(PG8_SB(0, 1), cB + hstep, voffB); PG8_STAGE(PG8_SA(0, 1), cA + hstep, voffA);
        if (wr == 1) PG8_BAR;
        PG8_WAIT_V(4); PG8_BAR;
        PG8_STAGE(PG8_SB(1, 0), cB + kstep, voffB); PG8_STAGE(PG8_SA(1, 0), cA + kstep, voffA); PG8_STAGE(PG8_SB(1, 1), cB + hstep + kstep, voffB);
        PG8_WAIT_V(6); PG8_BAR;
    }
    for (;;) {
        const bool has_next = S.next(ui + 1, nxt);
        const char* nA = has_next ? (const char*)g.A + (size_t)nxt.pm * tstep : cA; const char* nB = has_next ? (const char*)g.Bt + (size_t)nxt.pn * tstep : cB;
        for (int t = 0; t < nt; t += 2) {
            const bool last = (t == nt - 2);
            const char* a1 = cA + (size_t)(t + 1) * kstep;
            const char* a2 = last ? nA : cA + (size_t)(t + 2) * kstep; const char* b2 = last ? nB : cB + (size_t)(t + 2) * kstep;
            const char* a3 = a2 + kstep; const char* b3 = b2 + kstep;
            if (last && has_next) S.a_ready(nxt);
            if constexpr (SP2) {
            PG8_LDB(B0, 0, 0); PG8_LDB(B1, 0, 1); PG8_SCHED; PG8_LDA(At, 0, 0); PG8_STAGE(PG8_SA(1, 1), a1 + hstep, voffA);
            PG8_WAIT_V(8); PG8_WAIT_L(0); PG8_BAR; PG8_MMA(0, 0, At, B0); PG8_MMA(0, 1, At, B1); PG8_BAR; PG8_SCHED;
            PG8_LDA(At, 0, 1); PG8_STAGE(PG8_SB(0, 0), b2, voffB); PG8_STAGE(PG8_SB(0, 1), b2 + hstep, voffB); PG8_STAGE(PG8_SA(0, 0), a2, voffA);
            PG8_WAIT_V(8); PG8_WAIT_L(0); PG8_BAR; PG8_MMA(1, 0, At, B0); PG8_MMA(1, 1, At, B1); PG8_BAR; PG8_SCHED;
            PG8_LDB(B0, 1, 0); PG8_LDB(B1, 1, 1); PG8_SCHED; PG8_LDA(At, 1, 0); PG8_STAGE(PG8_SA(0, 1), a2 + hstep, voffA);
            PG8_WAIT_V(8); PG8_WAIT_L(0); PG8_BAR; PG8_MMA(0, 0, At, B0); PG8_MMA(0, 1, At, B1); PG8_BAR; PG8_SCHED;
            PG8_LDA(At, 1, 1); PG8_STAGE(PG8_SB(1, 0), b3, voffB); PG8_STAGE(PG8_SB(1, 1), b3 + hstep, voffB); PG8_STAGE(PG8_SA(1, 0), a3, voffA);
            PG8_WAIT_V(8); PG8_WAIT_L(0); PG8_BAR; PG8_MMA(1, 0, At, B0); PG8_MMA(1, 1, At, B1); PG8_BAR; PG8_SCHED;
            } else {
            PG8_LDB(B0, 0, 0); PG8_SCHED; PG8_LDA(At, 0, 0); PG8_STAGE(PG8_SA(1, 1), a1 + hstep, voffA);
            PG8_WAIT_L(8); PG8_BAR; PG8_WAIT_L(0); PG8_MMA(0, 0, At, B0); PG8_BAR; PG8_SCHED;
            PG8_LDB(B1, 0, 1); PG8_STAGE(PG8_SB(0, 0), b2, voffB);
            PG8_BAR; PG8_WAIT_L(0); PG8_MMA(0, 1, At, B1); PG8_BAR;
            PG8_LDA(At, 0, 1); PG8_STAGE(PG8_SA(0, 0), a2, voffA);
            PG8_BAR; PG8_WAIT_L(0); PG8_MMA(1, 0, At, B0); PG8_BAR; PG8_SCHED;
            PG8_STAGE(PG8_SB(0, 1), b2 + hstep, voffB);
            PG8_WAIT_V(6); PG8_BAR; PG8_MMA(1, 1, At, B1); PG8_BAR;
            PG8_LDB(B0, 1, 0); PG8_SCHED; PG8_LDA(At, 1, 0); PG8_STAGE(PG8_SA(0, 1), a2 + hstep, voffA);
            PG8_WAIT_L(8); PG8_BAR; PG8_WAIT_L(0); PG8_MMA(0, 0, At, B0); PG8_BAR; PG8_SCHED;
            PG8_LDB(B1, 1, 1); PG8_STAGE(PG8_SB(1, 0), b3, voffB);
            PG8_BAR; PG8_WAIT_L(0); PG8_MMA(0, 1, At, B1); PG8_BAR;
            PG8_LDA(At, 1, 1); PG8_STAGE(PG8_SA(1, 0), a3, voffA);
            PG8_BAR; PG8_WAIT_L(0); PG8_MMA(1, 0, At, B0); PG8_BAR; PG8_SCHED;
            PG8_STAGE(PG8_SB(1, 1), b3 + hstep, voffB);
            PG8_WAIT_V(6); PG8_BAR; PG8_MMA(1, 1, At, B1); PG8_BAR;
            }
        }
        if constexpr (ALIGN_EPI) { if (wr == 0) PG8_BAR; }
        if constexpr (!Epi::AFTER_DRAIN) { E(acc, cur, wr, wc, fr, fq); S.done(cur); }
        if (!has_next) break;
#pragma unroll
        for (int a = 0; a < 2; ++a)
#pragma unroll
            for (int b = 0; b < 2; ++b)
#pragma unroll
                for (int m = 0; m < 4; ++m)
#pragma unroll
                    for (int n = 0; n < 2; ++n) acc[a][b][m][n] = (f32x4){0.f, 0.f, 0.f, 0.f};
        cur = nxt; cA = nA; cB = nB; ++ui;
        if constexpr (ALIGN_EPI) { if (wr == 1) PG8_BAR; }
    }
    PG8_WAIT_V(0);
    if constexpr (!ALIGN_EPI) { if (wr == 0) PG8_BAR; }
    PG8_BAR;
    if constexpr (Epi::AFTER_DRAIN) { E.fused(acc, cur, wr, wc, fr, fq, lds, wid, lane); S.done(cur); }
#undef PG8_SA
#undef PG8_SB
#undef PG8_STAGE
#undef PG8_LDA
#undef PG8_LDB
#undef PG8_MMA
#undef PG8_WAIT_V
#undef PG8_WAIT_L
#undef PG8_BAR
#undef PG8_SCHED
}
}
constexpr size_t MiB = 1u << 20;
constexpr size_t WS_CTL = 0, CTL_ZERO_BYTES = 1 * MiB;
constexpr size_t WS_MODV = 1 * MiB;
constexpr size_t WS_ROPE = 2 * MiB;
constexpr size_t WS_VSTAT = 3 * MiB;
constexpr size_t WS_WS = 6 * MiB;
constexpr size_t WS_WIN = 8 * MiB;
constexpr size_t WS_WOUT = WS_WIN + 32 * MiB;
constexpr size_t WS_WQKV = WS_WOUT + 16 * MiB;
constexpr size_t WS_WO = WS_WQKV + 20 * MiB;
constexpr size_t WS_WGU = WS_WO + 16 * MiB;
constexpr size_t WS_WDN = WS_WGU + 176 * MiB;
constexpr size_t WS_XS = WS_WDN + 88 * MiB;
constexpr size_t WS_H = WS_XS + 72 * MiB;
constexpr size_t WS_UV = WS_H + 36 * MiB;
constexpr size_t WS_T = WS_UV + 72 * MiB;
constexpr size_t WS_Y = WS_T + 36 * MiB;
constexpr size_t WS_ACT = WS_Y + 72 * MiB;
constexpr size_t WS_END = WS_ACT + 99 * MiB;
constexpr int CW_BAR = 4096;

constexpr int LDS_BYTES = 155648;
constexpr int MISC_OFF = 153600;
constexpr int NWAVES = 8;

#define GAS __attribute__((address_space(1)))
#define LAS __attribute__((address_space(3)))
typedef unsigned short bf16;
typedef unsigned v4u __attribute__((ext_vector_type(4)));
typedef unsigned v2u __attribute__((ext_vector_type(2)));
typedef float f32x4 __attribute__((ext_vector_type(4)));
typedef float f32x2 __attribute__((ext_vector_type(2)));
typedef float f32x16 __attribute__((ext_vector_type(16)));
typedef short bf16x8 __attribute__((ext_vector_type(8)));
typedef short s16x4 __attribute__((ext_vector_type(4)));
typedef GAS unsigned gu32;
#define LDS_WAIT() asm volatile("s_waitcnt lgkmcnt(0)" ::: "memory")
__device__ __forceinline__ unsigned f2bf(float f) { unsigned u = __builtin_bit_cast(unsigned, f); return (u + 0x7fffu + ((u >> 16) & 1u)) >> 16; }
__device__ __forceinline__ unsigned pk2(float lo, float hi) { return f2bf(lo) | (f2bf(hi) << 16); }
__device__ __forceinline__ float bflo(unsigned w) { return __builtin_bit_cast(float, w << 16); }
__device__ __forceinline__ float bfhi(unsigned w) { return __builtin_bit_cast(float, w & 0xffff0000u); }
__device__ __forceinline__ float wave_sum(float v) {
#pragma unroll
    for (int o = 1; o < 64; o <<= 1) v += __shfl_xor(v, o);
    return v;
}
#define XB_TMO      128
#define XB_XCNT(j)  (256  + 64 * (j))
#define XB_XSUB(j)  (1280 + 64 * (j))
#define XB_XGEN(j)  (2304 + 64 * (j))
#define XB_TOP      3328
#define XB_TOPGEN   3392
#define XCD_BAR_WORDS 3456
#define XB_SPIN_CAP (1u << 18)

__device__ __forceinline__ unsigned xb_ld(unsigned* p)              { return __hip_atomic_load(p, __ATOMIC_RELAXED, __HIP_MEMORY_SCOPE_AGENT); }
__device__ __forceinline__ unsigned xb_add(unsigned* p, unsigned v) { return __hip_atomic_fetch_add(p, v, __ATOMIC_RELAXED, __HIP_MEMORY_SCOPE_AGENT); }
__device__ __forceinline__ unsigned xb_xcc_id() { return (unsigned)__builtin_amdgcn_s_getreg((3 << 11) | 20) & 0xFu; }
#define XB_SPIN(cond, bar) do { unsigned _sp = 0; while (cond) { __builtin_amdgcn_s_sleep(1); \
    if ((++_sp & 255u) == 0u) { if (xb_ld(&(bar)[XB_TMO])) break; if (_sp > XB_SPIN_CAP) { atomicAdd(&(bar)[XB_TMO], 1u); break; } } } } while (0)

struct XcdBarrier {
    unsigned* bar; unsigned x;
    volatile LAS unsigned* st;
};

__device__ __forceinline__ XcdBarrier xcd_barrier_post(unsigned* bar, volatile LAS unsigned* st) {
    XcdBarrier b; b.bar = bar; b.x = xb_xcc_id(); b.st = st;
    if (threadIdx.x == 0) (void)xb_add(&bar[XB_XCNT(b.x)], 1u);
    return b;
}
__device__ __forceinline__ void xcd_barrier_complete(unsigned* bar, unsigned x, unsigned& nloc, unsigned& nx) {
    const unsigned G = gridDim.x * gridDim.y * gridDim.z;
    unsigned sum, cnt, mine, sp = 0u;
    for (;;) {
        sum = 0u; cnt = 0u; mine = 0u;
#pragma unroll
        for (unsigned j = 0; j < 16; ++j) { const unsigned c = xb_ld(&bar[XB_XCNT(j)]); sum += c; cnt += (c > 0u) ? 1u : 0u; mine = (j == x) ? c : mine; }
        if (sum == G) break;
        __builtin_amdgcn_s_sleep(1);
        if ((++sp & 255u) == 0u) { if (xb_ld(&bar[XB_TMO])) break; if (sp > XB_SPIN_CAP) { atomicAdd(&bar[XB_TMO], 1u); break; } }
    }
    nloc = mine > 0u ? mine : 1u; nx = cnt > 0u ? cnt : 1u;
}

__device__ __forceinline__ void xcd_barrier(const XcdBarrier& b) {
    asm volatile("s_waitcnt vmcnt(0)" ::: "memory");
    __syncthreads();
    if (threadIdx.x == 0) {
        unsigned* bar = b.bar;
        __builtin_amdgcn_s_waitcnt(0);
        unsigned nloc = b.st[0], nx = b.st[1];
        if (nloc == 0u) { xcd_barrier_complete(bar, b.x, nloc, nx); b.st[0] = nloc; b.st[1] = nx; }
        const unsigned old = xb_add(&bar[XB_XSUB(b.x)], 1u);
        const unsigned gen = old / nloc;
        if (old + 1u == (gen + 1u) * nloc) {
            __builtin_amdgcn_fence(__ATOMIC_RELEASE, "agent");
            asm volatile("s_waitcnt vmcnt(0)" ::: "memory");
            const unsigned og = xb_add(&bar[XB_TOP], 1u);
            const unsigned tg = og / nx;
            if (og + 1u == (tg + 1u) * nx) xb_add(&bar[XB_TOPGEN], 1u);
            else XB_SPIN(xb_ld(&bar[XB_TOPGEN]) == tg, bar);
            __builtin_amdgcn_fence(__ATOMIC_ACQUIRE, "agent");
            xb_add(&bar[XB_XGEN(b.x)], 1u);
            asm volatile("s_waitcnt vmcnt(0)" ::: "memory");
        } else {
            XB_SPIN(xb_ld(&bar[XB_XGEN(b.x)]) == gen, bar);
            __builtin_amdgcn_fence(__ATOMIC_ACQUIRE, "agent");
            asm volatile("s_waitcnt vmcnt(0)" ::: "memory");
        }
    }
    __syncthreads();
}
struct Frame {
    LAS unsigned char* lds;
    int tid, lane, wave, vcu, G;
};

__device__ __forceinline__ void conv_item(const float* __restrict__ W, int K, int N, bf16* __restrict__ WT, int dst_row0, int k0, int n0, LAS float* scr, int lane) {
    f32x4 v[16];
#pragma unroll
    for (int i = 0; i < 16; ++i) v[i] = *(const GAS f32x4*)(W + (size_t)(k0 + 4 * i + (lane >> 4)) * N + n0 + 4 * (lane & 15));
#pragma unroll
    for (int i = 0; i < 16; ++i) { LAS float* s = scr + (4 * i + (lane >> 4)) * 65 + 4 * (lane & 15); s[0] = v[i].x; s[1] = v[i].y; s[2] = v[i].z; s[3] = v[i].w; }
    LDS_WAIT(); asm volatile("" ::: "memory");
    const int c = lane & 7;
#pragma unroll
    for (int j = 0; j < 8; ++j) { const int n = (lane >> 3) + 8 * j; const LAS float* s = scr + (8 * c) * 65 + n;
        v4u o; o.x = pk2(s[0 * 65], s[1 * 65]); o.y = pk2(s[2 * 65], s[3 * 65]); o.z = pk2(s[4 * 65], s[5 * 65]); o.w = pk2(s[6 * 65], s[7 * 65]);
        *(GAS v4u*)(WT + (size_t)(dst_row0 + n) * K + k0 + 8 * c) = o; }
    LDS_WAIT(); asm volatile("" ::: "memory");
}
struct P0Args { const float *c, *c_ctx, *w_mod, *b_mod, *norm_g, *a_w_in, *a_w_s, *a_w_out, *b_w_qkv, *b_w_o, *f_w_gu, *f_w_down; unsigned char* ws; };
constexpr int IT_IN = 32 * 64, IT_OUT = 32 * 32, IT_QKV = 32 * 40, IT_O = 32 * 32, IT_GU = 32 * 176, IT_DN = 88 * 32;
constexpr int IT_TOTAL = 2 * IT_IN + 2 * IT_OUT + 2 * IT_QKV + 2 * IT_O + 4 * IT_GU + 4 * IT_DN;
__device__ __forceinline__ void p0_convert(const Frame& F, const P0Args& a) {
    LAS float* scr = (LAS float*)(F.lds + F.wave * 16640);
    const int gw = F.vcu * NWAVES + F.wave, NGW = F.G * NWAVES;
    for (int it = gw; it < IT_TOTAL; it += NGW) {
        int r = it; const float* W; bf16* WT; int K, N; bool gu = false;
        if (r < 2 * IT_IN) { const int j = r / IT_IN; r -= j * IT_IN; W = a.a_w_in + (size_t)j * D * 2 * D; WT = (bf16*)(a.ws + WS_WIN) + (size_t)j * 2 * D * D; K = D; N = 2 * D; }
        else if ((r -= 2 * IT_IN) < 2 * IT_OUT) { const int j = r / IT_OUT; r -= j * IT_OUT; W = a.a_w_out + (size_t)j * D * D; WT = (bf16*)(a.ws + WS_WOUT) + (size_t)j * D * D; K = D; N = D; }
        else if ((r -= 2 * IT_OUT) < 2 * IT_QKV) { const int j = r / IT_QKV; r -= j * IT_QKV; W = a.b_w_qkv + (size_t)j * D * NQKV; WT = (bf16*)(a.ws + WS_WQKV) + (size_t)j * NQKV * D; K = D; N = NQKV; }
        else if ((r -= 2 * IT_QKV) < 2 * IT_O) { const int j = r / IT_O; r -= j * IT_O; W = a.b_w_o + (size_t)j * D * D; WT = (bf16*)(a.ws + WS_WO) + (size_t)j * D * D; K = D; N = D; }
        else if ((r -= 2 * IT_O) < 4 * IT_GU) { const int j = r / IT_GU; r -= j * IT_GU; W = a.f_w_gu + (size_t)j * D * 2 * FF; WT = (bf16*)(a.ws + WS_WGU) + (size_t)j * 2 * FF * D; K = D; N = 2 * FF; gu = true; }
        else { r -= 4 * IT_GU; const int j = r / IT_DN; r -= j * IT_DN; W = a.f_w_down + (size_t)j * FF * D; WT = (bf16*)(a.ws + WS_WDN) + (size_t)j * D * FF; K = FF; N = D; }
        const int nblk = N / 64, kb = r / nblk, nb = r % nblk, n0 = 64 * nb;
        int drow = n0;
        if (gu) { const int isu = n0 >= FF ? 1 : 0, nn = n0 - isu * FF; drow = (nn >> 7) * 256 + isu * 128 + (nn & 127); }
        conv_item(W, K, N, WT, drow, 64 * kb, n0, scr, F.lane);
    }
    for (int i = F.vcu * 512 + F.tid; i < 2 * 16 * 128 * 128 / 8; i += F.G * 512) {
        const f32x4 x0 = *(const GAS f32x4*)(a.a_w_s + (size_t)i * 8), x1 = *(const GAS f32x4*)(a.a_w_s + (size_t)i * 8 + 4);
        v4u o; o.x = pk2(x0.x, x0.y); o.y = pk2(x0.z, x0.w); o.z = pk2(x1.x, x1.y); o.w = pk2(x1.z, x1.w);
        *(GAS v4u*)((bf16*)(a.ws + WS_WS) + (size_t)i * 8) = o;
    }
    { const int i = F.vcu * 512 + F.tid; if (i < 1024) { const int pos = i >> 4, f = i & 15; const float inv = powf(10000.f, -(float)f / 16.f), ang = (float)pos * inv;
        float* rp = (float*)(a.ws + WS_ROPE); rp[i] = cosf(ang); rp[1024 + i] = sinf(ang); } }
}
__device__ __forceinline__ void p0_mod(const Frame& F, const P0Args& a) {
    LAS float* SV = (LAS float*)(F.lds);
    LAS float* RED = (LAS float*)(F.lds + 40960);
    if (F.vcu >= 192) return;
    for (int i = F.tid; i < 5 * D; i += 512) { const int r = i >> 11, k = i & 2047; const float c = r < 4 ? a.c[r * D + k] : a.c_ctx[k]; SV[i] = c / (1.f + __expf(-c)); }
    __syncthreads();
    for (int task = F.vcu; task < 192; task += F.G) {
        const int l = task / 48, cg = task % 48;
        const float* wp = a.w_mod + (size_t)l * D * (NMOD * D) + (size_t)(256 * F.wave) * (NMOD * D) + 256 * cg + 4 * F.lane;
        f32x4 acc[5];
#pragma unroll
        for (int r = 0; r < 5; ++r) acc[r] = (f32x4){0.f, 0.f, 0.f, 0.f};
#pragma unroll 2
        for (int k0 = 0; k0 < 256; k0 += 4) {
            const f32x4 w0 = *(const GAS f32x4*)(wp + (size_t)(k0 + 0) * (NMOD * D)), w1 = *(const GAS f32x4*)(wp + (size_t)(k0 + 1) * (NMOD * D));
            const f32x4 w2 = *(const GAS f32x4*)(wp + (size_t)(k0 + 2) * (NMOD * D)), w3 = *(const GAS f32x4*)(wp + (size_t)(k0 + 3) * (NMOD * D));
#pragma unroll
            for (int r = 0; r < 5; ++r) { const f32x4 s = *(const LAS f32x4*)(SV + r * D + 256 * F.wave + k0); acc[r] += s.x * w0 + s.y * w1 + s.z * w2 + s.w * w3; }
        }
#pragma unroll
        for (int r = 0; r < 5; ++r) *(LAS f32x4*)(RED + (F.wave * 5 + r) * 256 + 4 * F.lane) = acc[r];
        __syncthreads();
        for (int o = F.tid; o < 1280; o += 512) {
            const int r = o >> 8, cc = o & 255; float v = 0.f;
#pragma unroll
            for (int w = 0; w < 8; ++w) v += RED[(w * 5 + r) * 256 + cc];
            const int col = 256 * cg + cc, t = col >> 11, c2 = col & 2047; v += a.b_mod[l * (NMOD * D) + col];
            const float* ng = a.norm_g + (size_t)l * 4 * D;
            if (t == 1) v = ng[0 * D + c2] * (1.f + v); else if (t == 4) v = ng[2 * D + c2] * (1.f + v); else if (t == 2) v = ng[1 * D + c2] * v; else if (t == 5) v = ng[3 * D + c2] * v;
            ((float*)(a.ws + WS_MODV))[((size_t)(l * 5 + r) * 6 + t) * D + c2] = v;
        }
        __syncthreads();
    }
}

__device__ __forceinline__ int mod_index(int row) { return row < RL ? (row >> 11) : 4; }
__device__ __forceinline__ void store_h(bf16* hrow, int lane, const f32x4 (&x)[8], float rs, const float* __restrict__ gs, const float* __restrict__ sh) {
    GAS v2u* o8 = (GAS v2u*)hrow + lane;
#pragma unroll
    for (int j = 0; j < 8; ++j) { const f32x4 s = ((const GAS f32x4*)gs)[lane + 64 * j], b = ((const GAS f32x4*)sh)[lane + 64 * j]; const f32x4 h = (x[j] * rs) * s + b;
        v2u w; w.x = pk2(h.x, h.y); w.y = pk2(h.z, h.w); o8[64 * j] = w; }
}
__device__ __forceinline__ void thin_norm_row(int lane, const float* __restrict__ xrow, const float* __restrict__ gs, const float* __restrict__ sh, bf16* hrow) {
    f32x4 x[8]; float ss = 0.f;
#pragma unroll
    for (int j = 0; j < 8; ++j) { x[j] = ((const GAS f32x4*)xrow)[lane + 64 * j]; ss += (x[j].x * x[j].x + x[j].y * x[j].y) + (x[j].z * x[j].z + x[j].w * x[j].w); }
    const float rs = rsqrtf(wave_sum(ss) * (1.f / D) + EPS);
    store_h(hrow, lane, x, rs, gs, sh);
}
__device__ __forceinline__ void thin_resid_row(int lane, const float* xsrc, const float* __restrict__ yrow, const float* __restrict__ gg, float* xdst, const float* __restrict__ gs, const float* __restrict__ sh, bf16* hrow) {
    f32x4 y[8]; float ss = 0.f;
#pragma unroll
    for (int j = 0; j < 8; ++j) { y[j] = ((const GAS f32x4*)yrow)[lane + 64 * j]; ss += (y[j].x * y[j].x + y[j].y * y[j].y) + (y[j].z * y[j].z + y[j].w * y[j].w); }
    const float rs = rsqrtf(wave_sum(ss) * (1.f / D) + EPS);
    f32x4 x[8]; float sx = 0.f;
#pragma unroll
    for (int j = 0; j < 8; ++j) { const f32x4 g = ((const GAS f32x4*)gg)[lane + 64 * j]; x[j] = ((const GAS f32x4*)xsrc)[lane + 64 * j] + g * (y[j] * rs);
        ((GAS f32x4*)xdst)[lane + 64 * j] = x[j]; sx += (x[j].x * x[j].x + x[j].y * x[j].y) + (x[j].z * x[j].z + x[j].w * x[j].w); }
    if (hrow) { const float rx = rsqrtf(wave_sum(sx) * (1.f / D) + EPS); store_h(hrow, lane, x, rx, gs, sh); }
}

__device__ __forceinline__ unsigned sg_off(unsigned row, unsigned ch) { return 256u * row + 16u * (ch ^ (((row & 3) << 2) | ((row >> 2) & 3))); }
__device__ __forceinline__ s16x4 tr16(const LAS unsigned char* p) { typedef short v4i16_t __attribute__((ext_vector_type(4))); return __builtin_bit_cast(s16x4, __builtin_amdgcn_ds_read_tr16_b64_v4i16((LAS v4i16_t*)p)); }
__device__ __forceinline__ void sg_unit(const Frame& F, int chunk, int g, const bf16* __restrict__ UV, const float* __restrict__ vstat, const float* __restrict__ vg, const bf16* __restrict__ WSb  , const float* __restrict__ bs  , bf16* __restrict__ T) {
    const int row0 = chunk * 128, tid = F.tid, lane = F.lane, wave = F.wave;
    LAS unsigned char* img = F.lds;
    {
        const int q = tid >> 2, qu = tid & 3;
        const f32x2* ps = (const f32x2*)vstat + (size_t)(row0 + q) * 32 + 8 * qu; float s1 = 0.f, s2 = 0.f;
#pragma unroll
        for (int i = 0; i < 8; ++i) { const f32x2 p = ps[i]; s1 += p.x; s2 += p.y; }
        s1 += __shfl_xor(s1, 1); s2 += __shfl_xor(s2, 1); s1 += __shfl_xor(s1, 2); s2 += __shfl_xor(s2, 2);
        const float mu = s1 * (1.f / D); const float var = fmaxf(s2 * (1.f / D) - mu * mu, 0.f); const float rstd = rsqrtf(var + EPS);
        const bf16* vp = UV + (size_t)(row0 + q) * 4096 + 2048 + g * 128 + 32 * qu; const float* gp = vg + g * 128 + 32 * qu;
        v4u raw[4];
#pragma unroll
        for (int i = 0; i < 4; ++i) raw[i] = *(const GAS v4u*)(vp + 8 * i);
#pragma unroll
        for (int i = 0; i < 4; ++i) { const f32x4 g0 = *(const GAS f32x4*)(gp + 8 * i), g1 = *(const GAS f32x4*)(gp + 8 * i + 4); v4u o;
            o.x = pk2((bflo(raw[i].x) - mu) * rstd * g0.x, (bfhi(raw[i].x) - mu) * rstd * g0.y); o.y = pk2((bflo(raw[i].y) - mu) * rstd * g0.z, (bfhi(raw[i].y) - mu) * rstd * g0.w);
            o.z = pk2((bflo(raw[i].z) - mu) * rstd * g1.x, (bfhi(raw[i].z) - mu) * rstd * g1.y); o.w = pk2((bflo(raw[i].w) - mu) * rstd * g1.z, (bfhi(raw[i].w) - mu) * rstd * g1.w);
            *(LAS v4u*)(img + sg_off(q, 4 * qu + i)) = o; }
    }
    bf16x8 bfr[4];
#pragma unroll
    for (int ks = 0; ks < 4; ++ks) bfr[ks] = *(const GAS bf16x8*)(WSb + ((size_t)g * 128 + 16 * wave + (lane & 15)) * 128 + 32 * ks + 8 * (lane >> 4));
    const int p = 16 * wave + (lane & 15); const float bias = bs[g * 128 + p]; const size_t ro = (size_t)(row0 + p);
    __syncthreads();
    const unsigned lg = lane >> 4, lq = (lane & 15) >> 2, lp = lane & 3;
#pragma unroll 4
    for (int ct = 0; ct < 8; ++ct) {
        f32x4 acc = {0.f, 0.f, 0.f, 0.f};
#pragma unroll
        for (int ks = 0; ks < 4; ++ks) {
            const s16x4 lo = tr16(img + sg_off(32 * ks + 8 * lg + lq, 2 * ct + (lp >> 1)) + 8 * (lp & 1));
            const s16x4 hi = tr16(img + sg_off(32 * ks + 8 * lg + 4 + lq, 2 * ct + (lp >> 1)) + 8 * (lp & 1));
            const bf16x8 af = (bf16x8){lo[0], lo[1], lo[2], lo[3], hi[0], hi[1], hi[2], hi[3]};
            acc = __builtin_amdgcn_mfma_f32_16x16x32_bf16(af, bfr[ks], acc, 0, 0, 0);
        }
        const int cc = g * 128 + 16 * ct + 4 * lg;
        const v2u uu = *(const GAS v2u*)(UV + ro * 4096 + cc);
        v2u w; w.x = pk2(bflo(uu.x) * (acc[0] + bias), bfhi(uu.x) * (acc[1] + bias)); w.y = pk2(bflo(uu.y) * (acc[2] + bias), bfhi(uu.y) * (acc[3] + bias));
        *(GAS v2u*)(T + ro * 2048 + cc) = w;
    }
    __syncthreads();
}

constexpr int ATT_KROW = 144, ATT_NKEY = 544, ATT_VOFF = ATT_NKEY * ATT_KROW;
static_assert(ATT_VOFF + ATT_NKEY * 128 <= MISC_OFF, "attention LDS");
__device__ __forceinline__ int crow(int r, int hi) { return (r & 3) + 8 * (r >> 2) + 4 * hi; }
__device__ __forceinline__ void att_tile(const LAS unsigned char* kt, const LAS unsigned char* vt, const bf16x8 (&qf)[4], float& m, float& l, f32x16& o0, f32x16& o1, int maskmode, int r, int h) {
    f32x16 s = {0.f, 0.f, 0.f, 0.f, 0.f, 0.f, 0.f, 0.f, 0.f, 0.f, 0.f, 0.f, 0.f, 0.f, 0.f, 0.f};
#pragma unroll
    for (int st = 0; st < 4; ++st) { const bf16x8 kf = *(const LAS bf16x8*)(kt + r * ATT_KROW + 32 * st + 16 * h); s = __builtin_amdgcn_mfma_f32_32x32x16_bf16(kf, qf[st], s, 0, 0, 0); }
    if (maskmode) {
#pragma unroll
        for (int i = 0; i < 16; ++i) { const int ko = crow(i, h); const bool bad = maskmode == 1 ? (ko < r) : (ko > r); if (bad) s[i] = -1e30f; }
    }
    float tm = s[0];
#pragma unroll
    for (int i = 1; i < 16; ++i) tm = fmaxf(tm, s[i]);
    tm = fmaxf(tm, __shfl_xor(tm, 32));
    const float mn = fmaxf(m, tm), corr = __builtin_amdgcn_exp2f(m - mn); m = mn;
    float ps = 0.f;
#pragma unroll
    for (int i = 0; i < 16; ++i) { s[i] = __builtin_amdgcn_exp2f(s[i] - mn); ps += s[i]; }
    l = l * corr + ps;
#pragma unroll
    for (int i = 0; i < 16; ++i) { o0[i] *= corr; o1[i] *= corr; }
    v4u pw0, pw1;
    pw0.x = pk2(s[0], s[1]); pw0.y = pk2(s[2], s[3]); pw0.z = pk2(s[4], s[5]); pw0.w = pk2(s[6], s[7]);
    pw1.x = pk2(s[8], s[9]); pw1.y = pk2(s[10], s[11]); pw1.z = pk2(s[12], s[13]); pw1.w = pk2(s[14], s[15]);
    const bf16x8 pb0 = __builtin_bit_cast(bf16x8, pw0), pb1 = __builtin_bit_cast(bf16x8, pw1);
#define ATT_VA(s2, dt) ({ const s16x4 lo_ = tr16(vt + (s2) * 2048 + (dt) * 512), hi_ = tr16(vt + (s2) * 2048 + 1024 + (dt) * 512); (bf16x8){lo_[0], lo_[1], lo_[2], lo_[3], hi_[0], hi_[1], hi_[2], hi_[3]}; })
    o0 = __builtin_amdgcn_mfma_f32_32x32x16_bf16(ATT_VA(0, 0), pb0, o0, 0, 0, 0);
    o0 = __builtin_amdgcn_mfma_f32_32x32x16_bf16(ATT_VA(1, 0), pb1, o0, 0, 0, 0);
    o1 = __builtin_amdgcn_mfma_f32_32x32x16_bf16(ATT_VA(0, 1), pb0, o1, 0, 0, 0);
    o1 = __builtin_amdgcn_mfma_f32_32x32x16_bf16(ATT_VA(1, 1), pb1, o1, 0, 0, 0);
#undef ATT_VA
}
__device__ __forceinline__ void att_unit(const Frame& F, const bf16* __restrict__ QKV, const float* __restrict__ sink, bf16* __restrict__ O, int b, int kvh, int s0, int t0) {
    const int tid = F.tid, lane = F.lane, wave = F.wave, r = lane & 31, h = lane >> 5;
    LAS unsigned char* lds = F.lds;
    int kt_lo = 1, kt_hi = 0;
    if (s0 >= 0) { kt_lo = s0 < 128 ? (128 - s0) >> 5 : 0; const int hi_ = (2144 - s0) >> 5; kt_hi = hi_ < 8 ? hi_ : 8; }
    {
        v4u kk[9], vv[9]; bool ok[9];
#pragma unroll
        for (int it = 0; it < 9; ++it) {
            const int c = tid + 512 * it, key = c >> 3, ch = c & 7; int row; bool good = key < ATT_NKEY;
            if (key < 256) row = RL + b * CTXL + key;
            else { const int kt = (key - 256) >> 5; good = good && kt >= kt_lo && kt <= kt_hi; row = b * SEQ + s0 - 128 + (key - 256); }
            ok[it] = good;
            if (good) { const bf16* p = QKV + (size_t)row * NQKV + 2048 + kvh * 64 + 8 * ch; kk[it] = *(const GAS v4u*)p; vv[it] = *(const GAS v4u*)(p + 256); }
        }
#pragma unroll
        for (int it = 0; it < 9; ++it) {
            const int c = tid + 512 * it, key = c >> 3, ch = c & 7;
            if (ok[it]) { *(LAS v4u*)(lds + key * ATT_KROW + 16 * ch) = kk[it];
                *(LAS v4u*)(lds + ATT_VOFF + (key >> 3) * 1024 + (ch >> 2) * 512 + (key & 7) * 64 + (ch & 3) * 16) = vv[it]; }
        }
    }
    const int hq = kvh * 8 + wave; const int qrow0 = s0 >= 0 ? b * SEQ + s0 : RL + b * CTXL + t0;
    bf16x8 qf[4];
#pragma unroll
    for (int st = 0; st < 4; ++st) qf[st] = *(const GAS bf16x8*)(QKV + (size_t)(qrow0 + r) * NQKV + hq * 64 + 16 * st + 8 * h);
    float m = sink[hq] * LOG2E, l = h == 0 ? 1.f : 0.f;
    f32x16 o0 = {0.f, 0.f, 0.f, 0.f, 0.f, 0.f, 0.f, 0.f, 0.f, 0.f, 0.f, 0.f, 0.f, 0.f, 0.f, 0.f}, o1 = o0;
    __syncthreads();
    const LAS unsigned char* vlane = lds + ATT_VOFF + (4 * h + ((lane & 15) >> 2)) * 64 + ((lane >> 4) & 1) * 32 + (lane & 3) * 8;
    for (int t = 0; t < 8; ++t) att_tile(lds + (32 * t) * ATT_KROW, vlane + (32 * t) * 128, qf, m, l, o0, o1, 0, r, h);
    for (int kt = kt_lo; kt <= kt_hi; ++kt) { const int key0 = 256 + 32 * kt; att_tile(lds + key0 * ATT_KROW, vlane + key0 * 128, qf, m, l, o0, o1, kt == 0 ? 1 : (kt == 8 ? 2 : 0), r, h); }
    l += __shfl_xor(l, 32);
    const float il = 1.f / l;
    bf16* op = O + (size_t)(qrow0 + r) * D + hq * 64 + 4 * h;
#pragma unroll
    for (int g4 = 0; g4 < 4; ++g4) {
        v2u w0, w1; w0.x = pk2(o0[4 * g4] * il, o0[4 * g4 + 1] * il); w0.y = pk2(o0[4 * g4 + 2] * il, o0[4 * g4 + 3] * il);
        w1.x = pk2(o1[4 * g4] * il, o1[4 * g4 + 1] * il); w1.y = pk2(o1[4 * g4 + 2] * il, o1[4 * g4 + 3] * il);
        *(GAS v2u*)(op + 8 * g4) = w0; *(GAS v2u*)(op + 32 + 8 * g4) = w1;
    }
    __syncthreads();
}
#if DEBUG_CHECK
namespace dbg {
template <typename T> __device__ __forceinline__ float ld(const T* p);
template <> __device__ __forceinline__ float ld<float>(const float* p) { return *p; }
template <> __device__ __forceinline__ float ld<bf16>(const bf16* p) { return __builtin_bit_cast(float, (unsigned)(*p) << 16); }
__device__ __forceinline__ void st(float* p, float v) { *p = v; }
__device__ __forceinline__ void st(bf16* p, float v) { *p = (bf16)f2bf(v); }

__global__ void k_mod(const float* __restrict__ c, const float* __restrict__ c_ctx, const float* __restrict__ w_mod, const float* __restrict__ b_mod, float* __restrict__ modv) {
    const int idx = blockIdx.x * 256 + threadIdx.x;
    const int n = idx % (NMOD * D), r = (idx / (NMOD * D)) % 5, l = idx / (NMOD * D * 5);
    const float* cv = r < 4 ? c + r * D : c_ctx;
    const float* w = w_mod + (size_t)l * D * (NMOD * D) + n;
    float acc = 0.f;
    for (int k = 0; k < D; ++k) { const float cc = cv[k]; const float s = cc / (1.f + expf(-cc)); acc += s * w[(size_t)k * (NMOD * D)]; }
    modv[idx] = acc + b_mod[l * (NMOD * D) + n];
}
__device__ __forceinline__ float block_sum256(float v, float* red) {
    for (int o = 32; o > 0; o >>= 1) v += __shfl_xor(v, o);
    __syncthreads();
    if ((threadIdx.x & 63) == 0) red[threadIdx.x >> 6] = v;
    __syncthreads();
    return red[0] + red[1] + red[2] + red[3];
}
__global__ void k_norm(const float* __restrict__ xs, const float* __restrict__ g, const float* __restrict__ modl, int sh_t, int sc_t, bf16* __restrict__ h) {
    __shared__ float red[4];
    const int row = blockIdx.x; const float* x = xs + (size_t)row * D;
    float v[8]; float ss = 0.f;
#pragma unroll
    for (int i = 0; i < 8; ++i) { v[i] = x[threadIdx.x + 256 * i]; ss += v[i] * v[i]; }
    ss = block_sum256(ss, red);
    const float rs = rsqrtf(ss * (1.f / D) + EPS);
    const float* m = modl + mod_index(row) * (NMOD * D);
#pragma unroll
    for (int i = 0; i < 8; ++i) { const int cidx = threadIdx.x + 256 * i; st(h + (size_t)row * D + cidx, (v[i] * rs * g[cidx]) * (1.f + m[sc_t * D + cidx]) + m[sh_t * D + cidx]); }
}
__global__ void k_resid(const float* xin, const float* __restrict__ y, const float* __restrict__ g, const float* __restrict__ modl, int gate_t, float* xout) {
    __shared__ float red[4];
    const int row = blockIdx.x; const float* yr = y + (size_t)row * D;
    float v[8]; float ss = 0.f;
#pragma unroll
    for (int i = 0; i < 8; ++i) { v[i] = yr[threadIdx.x + 256 * i]; ss += v[i] * v[i]; }
    ss = block_sum256(ss, red);
    const float rs = rsqrtf(ss * (1.f / D) + EPS);
    const float* m = modl + mod_index(row) * (NMOD * D);
#pragma unroll
    for (int i = 0; i < 8; ++i) { const int cidx = threadIdx.x + 256 * i; xout[(size_t)row * D + cidx] = xin[(size_t)row * D + cidx] + m[gate_t * D + cidx] * (v[i] * rs * g[cidx]); }
}
template <int EPI, typename TO>
__global__ void k_gemm(const bf16* __restrict__ A, const float* __restrict__ W, TO* __restrict__ C, int M, int N, int K, int ldw, int ldc) {
    __shared__ float As[16][64 + 4];
    __shared__ float Bs[16][64 + 4];
    __shared__ float B2[EPI == 2 ? 16 : 1][64 + 4];
    const int tx = threadIdx.x & 15, ty = threadIdx.x >> 4;
    const int m0 = blockIdx.y * 64, n0 = blockIdx.x * 64;
    float acc[4][4] = {}, acc2[4][4] = {};
    for (int k0 = 0; k0 < K; k0 += 16) {
#pragma unroll
        for (int i = 0; i < 4; ++i) { const int e = threadIdx.x + 256 * i; const int r = e >> 4, kk = e & 15; As[kk][r] = ld(A + (size_t)(m0 + r) * K + k0 + kk); }
#pragma unroll
        for (int i = 0; i < 4; ++i) { const int e = threadIdx.x + 256 * i; const int kk = e >> 6, cn = e & 63; Bs[kk][cn] = W[(size_t)(k0 + kk) * ldw + n0 + cn];
            if (EPI == 2) B2[kk][cn] = W[(size_t)(k0 + kk) * ldw + n0 + cn + FF]; }
        __syncthreads();
#pragma unroll
        for (int kk = 0; kk < 16; ++kk) {
            float a[4], b[4], b2[4];
#pragma unroll
            for (int i = 0; i < 4; ++i) { a[i] = As[kk][ty * 4 + i]; b[i] = Bs[kk][tx * 4 + i]; if (EPI == 2) b2[i] = B2[kk][tx * 4 + i]; }
#pragma unroll
            for (int i = 0; i < 4; ++i)
#pragma unroll
                for (int j = 0; j < 4; ++j) { acc[i][j] += a[i] * b[j]; if (EPI == 2) acc2[i][j] += a[i] * b2[j]; }
        }
        __syncthreads();
    }
#pragma unroll
    for (int i = 0; i < 4; ++i)
#pragma unroll
        for (int j = 0; j < 4; ++j) {
            const int row = m0 + ty * 4 + i, col = n0 + tx * 4 + j; float v = acc[i][j];
            if (EPI == 1) v = 0.5f * v * (1.f + erff(v * 0.70710678118654752f));
            if (EPI == 2) v = (v / (1.f + expf(-v))) * acc2[i][j];
            st(C + (size_t)row * ldc + col, v);
        }
}
__global__ void k_lnstats(const bf16* __restrict__ uv, float* __restrict__ stats) {
    __shared__ float red[4];
    const int row = blockIdx.x; const bf16* v = uv + (size_t)row * (2 * D) + D;
    float x[8]; float s = 0.f;
#pragma unroll
    for (int i = 0; i < 8; ++i) { x[i] = ld(v + threadIdx.x + 256 * i); s += x[i]; }
    s = block_sum256(s, red);
    const float mu = s * (1.f / D); float q = 0.f;
#pragma unroll
    for (int i = 0; i < 8; ++i) { const float d = x[i] - mu; q += d * d; }
    q = block_sum256(q, red);
    if (threadIdx.x == 0) { stats[2 * row] = mu; stats[2 * row + 1] = rsqrtf(q * (1.f / D) + EPS); }
}
__global__ void k_sg(const bf16* __restrict__ uv, const float* __restrict__ stats, const float* __restrict__ vg, const float* __restrict__ w_s, const float* __restrict__ b_s, bf16* __restrict__ T) {
    const int row = blockIdx.x; const int chunk = row >> 7, p = row & 127;
    for (int ch = threadIdx.x; ch < D; ch += 256) {
        const int g = ch >> 7; const float* ws = w_s + ((size_t)g * 128 + p) * 128; float acc = 0.f;
        for (int q = 0; q < 128; ++q) { const int r2 = chunk * 128 + q; const float vv = (ld(uv + (size_t)r2 * (2 * D) + D + ch) - stats[2 * r2]) * stats[2 * r2 + 1]; acc += ws[q] * vv; }
        acc = acc * vg[ch] + b_s[g * 128 + p];
        st(T + (size_t)row * D + ch, ld(uv + (size_t)row * (2 * D) + ch) * acc);
    }
}
__global__ void k_rope_scale(bf16* __restrict__ qkv, float qscale) {
    const size_t idx = (size_t)blockIdx.x * 256 + threadIdx.x;
    const int pr = idx & 31, hh = (idx >> 5) % 36, row = idx / (32 * 36);
    const int a = pr >> 4, f = pr & 15;
    bf16* base = qkv + (size_t)row * NQKV + hh * 64 + a * 32 + f;
    float x1 = ld(base), x2 = ld(base + 16);
    if (row < RL) { const int s = row & (SEQ - 1); const float pos = a == 0 ? (float)(s >> 6) : (float)(s & 63);
        const float inv = powf(10000.f, -(float)f / 16.f); const float ang = pos * inv; const float cs = cosf(ang), sn = sinf(ang);
        const float y1 = x1 * cs - x2 * sn, y2 = x2 * cs + x1 * sn; x1 = y1; x2 = y2; }
    const float sc = hh < 32 ? qscale : 1.f;
    st(base, x1 * sc); st(base + 16, x2 * sc);
}
__global__ void __launch_bounds__(64) k_attn(const bf16* __restrict__ qkv, const float* __restrict__ sink, bf16* __restrict__ O, int nrows) {
    const int idx = blockIdx.x * 64 + threadIdx.x; const int row = idx >> 5, hq = idx & 31; if (row >= nrows) return;
    const int kvh = hq >> 3;
    float q[64], o[64];
    const bf16* qp = qkv + (size_t)row * NQKV + hq * 64;
#pragma unroll
    for (int d = 0; d < 64; ++d) { q[d] = ld(qp + d); o[d] = 0.f; }
    float m = sink[hq] * LOG2E, l = 1.f;
    int b, k_lo, k_hi;
    if (row < RL) { b = row >> 11; const int s = row & (SEQ - 1); k_lo = s - 128 < 0 ? 0 : s - 128; k_hi = s + 128 > SEQ - 1 ? SEQ - 1 : s + 128; } else { b = (row - RL) >> 8; k_lo = 0; k_hi = -1; }
    const int nlat = k_hi - k_lo + 1;
    for (int j = 0; j < CTXL + nlat; ++j) {
        const int krow = j < CTXL ? RL + b * CTXL + j : b * SEQ + k_lo + (j - CTXL);
        const bf16* kp = qkv + (size_t)krow * NQKV + 2048 + kvh * 64; const bf16* vp = kp + 256;
        float sc = 0.f;
#pragma unroll
        for (int d = 0; d < 64; ++d) sc += q[d] * ld(kp + d);
        const float mn = fmaxf(m, sc), corr = exp2f(m - mn), pp = exp2f(sc - mn);
        l = l * corr + pp; m = mn;
#pragma unroll
        for (int d = 0; d < 64; ++d) o[d] = o[d] * corr + pp * ld(vp + d);
    }
    const float il = 1.f / l; bf16* op = O + (size_t)row * D + hq * 64;
#pragma unroll
    for (int d = 0; d < 64; ++d) st(op + d, o[d] * il);
}
__global__ void k_concat(const float* __restrict__ x, const float* __restrict__ ctx, float* __restrict__ xs) {
    const size_t i = (size_t)blockIdx.x * 256 + threadIdx.x; const size_t nl = (size_t)RL * D / 4;
    ((float4*)xs)[i] = i < nl ? ((const float4*)x)[i] : ((const float4*)ctx)[i - nl];
}
template <typename T>
__global__ void k_cmp(const T* __restrict__ a, const T* __restrict__ b, int rows, int cols, int ld_, float* err, int id) {
    __shared__ float red[4];
    float e = 0.f, s = 0.f;
    for (size_t i = (size_t)blockIdx.x * 256 + threadIdx.x; i < (size_t)rows * cols; i += (size_t)gridDim.x * 256) { const size_t r = i / cols, c = i % cols; const float x = ld(a + r * ld_ + c), y = ld(b + r * ld_ + c); const float d = x - y; e += d * d; s += y * y; }
    e = block_sum256(e, red); s = block_sum256(s, red);
    if (threadIdx.x == 0) { atomicAdd(err + 2 * id, e); atomicAdd(err + 2 * id + 1, s); }
}
__global__ void k_cmp_stats(const float* __restrict__ vstat, const float* __restrict__ truth, int rows, float* err, int id) {
    __shared__ float red[4];
    float e = 0.f, s = 0.f;
    for (int r = blockIdx.x * 256 + threadIdx.x; r < rows; r += gridDim.x * 256) { float s1 = 0.f, s2 = 0.f; for (int i = 0; i < 32; ++i) { s1 += vstat[((size_t)r * 32 + i) * 2]; s2 += vstat[((size_t)r * 32 + i) * 2 + 1]; }
        const float mu = s1 * (1.f / D), var = fmaxf(s2 * (1.f / D) - mu * mu, 0.f), rstd = rsqrtf(var + EPS); const float d0 = mu - truth[2 * r], d1 = rstd - truth[2 * r + 1];
        e += d0 * d0 + d1 * d1; s += truth[2 * r] * truth[2 * r] + truth[2 * r + 1] * truth[2 * r + 1]; }
    e = block_sum256(e, red); s = block_sum256(s, red);
    if (threadIdx.x == 0) { atomicAdd(err + 2 * id, e); atomicAdd(err + 2 * id + 1, s); }
}
__device__ __forceinline__ bool bad_id(const float* err, int i) { const float e = err[2 * i], s = err[2 * i + 1]; return !(e <= 4e-4f * s) || !(s > 0.f); }
__global__ void k_flag(const float* __restrict__ err, int n, float* out) {
    if (blockIdx.x == 0 && threadIdx.x == 0) { for (int i = 1; i < n; ++i) {
        if (i == 3 && bad_id(err, 40)) { out[0] += 40000.f; break; }
        if (i == 21 && bad_id(err, 42)) { out[0] += 42000.f; break; }
        if (bad_id(err, i)) { out[0] += 1000.f * (float)i; break; } } }
}
__global__ void k_cmp_part(const bf16* __restrict__ a, const bf16* __restrict__ b, int rows, int cols, int ld_, float* err, int id, int mode, int val) {
    __shared__ float red[4];
    float e = 0.f, s = 0.f;
    for (size_t i = (size_t)blockIdx.x * 256 + threadIdx.x; i < (size_t)rows * cols; i += (size_t)gridDim.x * 256) { const size_t r = i / cols, c = i % cols;
        const int key = mode == 0 ? (int)((c >> 7) & 7) : (int)((r >> 7) & 7); if (key != val) continue;
        const float x = ld(a + r * ld_ + c), y = ld(b + r * ld_ + c); const float dd = x - y; e += dd * dd; s += y * y; }
    e = block_sum256(e, red); s = block_sum256(s, red);
    if (threadIdx.x == 0) { atomicAdd(err + 2 * id, e); atomicAdd(err + 2 * id + 1, s); }
}
__global__ void k_cmp_wf(const bf16* __restrict__ a, const float* __restrict__ b, size_t n, float* err, int id) {
    __shared__ float red[4];
    float e = 0.f, s = 0.f;
    for (size_t i = (size_t)blockIdx.x * 256 + threadIdx.x; i < n; i += (size_t)gridDim.x * 256) { const float x = ld(a + i), y = b[i]; const float dd = x - y; e += dd * dd; s += y * y; }
    e = block_sum256(e, red); s = block_sum256(s, red);
    if (threadIdx.x == 0) { atomicAdd(err + 2 * id, e); atomicAdd(err + 2 * id + 1, s); }
}
__global__ void k_count_poison(const unsigned* __restrict__ p, size_t n, unsigned* cnt) {
    unsigned c = 0; for (size_t i = (size_t)blockIdx.x * 256 + threadIdx.x; i < n; i += (size_t)gridDim.x * 256) c += p[i] == 0xAAAAAAAAu ? 1u : 0u;
    if (c) atomicAdd(cnt, c);
}
__global__ void k_poison_pattern(const bf16* __restrict__ t, int rows, int cols, unsigned* flags  ) {
    for (size_t i = (size_t)blockIdx.x * 256 + threadIdx.x; i < (size_t)rows * cols; i += (size_t)gridDim.x * 256) { if (t[i] == 0xAAAAu) { const size_t r = i / cols, c = i % cols; flags[r & 127] = 1u; flags[128 + (c & 127)] = 1u; atomicAdd(flags + 256, 1u); } }
}
__global__ void k_flag3(const unsigned* __restrict__ flags, float* out) {
    if (blockIdx.x == 0 && threadIdx.x == 0) { int nr = 0, nc = 0; for (int i = 0; i < 128; ++i) { nr += flags[i] ? 1 : 0; nc += flags[128 + i] ? 1 : 0; }
        int a = 0, b = 0; while ((1 << a) < nr + 1) ++a; while ((1 << b) < nc + 1) ++b; out[0] += (float)(10 * a + b); }
}
__global__ void k_flag2(const float* __restrict__ err, float* out, int id_main, int id_a0, int id_b0) {
    const float e = err[2 * id_main], s = err[2 * id_main + 1];
    int code1 = (e > 0.f && s > 0.f) ? (int)rintf(10.f * log10f(s / e)) : (e == 0.f ? 99 : 1); code1 = code1 < 1 ? 1 : (code1 > 99 ? 99 : code1);
    const float e41 = err[2 * 41], s41 = err[2 * 41 + 1]; const int na = (!(e41 <= 1e-4f * s41) || !(s41 > 0.f)) ? 1 : 0;
    const unsigned pc = ((const unsigned*)err)[2 * 45]; int nb = 0; for (unsigned t = pc; t > 0; t /= 10) ++nb;
    const int code2 = 10 * na + nb;
    const size_t i = (size_t)blockIdx.x * 256 + threadIdx.x;
    if (i == 0) out[0] += (float)(code2 + 20);
}
}
#endif
constexpr int NPHASE = 2 + 7 * DEPTH;
struct Args { const float* in[17]; float* out; unsigned char* ws; unsigned char* altA; unsigned char* altB; int ph_lo, ph_hi; };
#define IN(k) (lo <= (k) && (k) < hi)
#define SEAM(k) do { if (IN(k) && IN((k) + 1)) xcd_barrier(bar); } while (0)
#define MV(l, r, t) (MODV + ((size_t)((l) * 5 + (r)) * 6 + (t)) * D)
template <int l>
__device__ __forceinline__ void layer(const Frame& F, const Args& args, const XcdBarrier& bar, const int lo, const int hi) {
    unsigned char* ws = args.ws;
    const float* x_in = args.in[0]; const float* ctx_in = args.in[2];
    const float* a_vg = args.in[8]; const float* a_bs = args.in[10]; const float* b_sink = args.in[13];
    float* XS = (float*)(ws + WS_XS); bf16* H = (bf16*)(ws + WS_H); bf16* UV = (bf16*)(ws + WS_UV); bf16* T = (bf16*)(ws + WS_T); float* Y = (float*)(ws + WS_Y); bf16* ACT = (bf16*)(ws + WS_ACT);
    const float* MODV = (const float*)(ws + WS_MODV); float* VSTAT = (float*)(ws + WS_VSTAT);
    const int gw = F.vcu * NWAVES + F.wave, NGW = F.G * NWAVES;
    bf16* UVo = args.altA ? (bf16*)args.altA : UV; bf16* To = args.altB ? (bf16*)args.altB : T; float* Yo = args.altA ? (float*)args.altA : Y; bf16* ACTo = args.altA ? (bf16*)args.altA : ACT;
    float* XSo = args.altA ? (float*)args.altA : XS; bf16* Ho = args.altB ? (bf16*)args.altB : H; float* OUTo = args.altA ? (float*)args.altA : args.out;
    {
        constexpr int pb = 2 + 7 * l, j = l >> 1; constexpr bool odd = (l & 1) != 0, last = l == DEPTH - 1; constexpr int Mact = last ? RL : R;
        if (IN(pb)) {
            if constexpr (!odd) { pg8::Gemm g{H, (const bf16*)(ws + WS_WIN) + (size_t)j * 2 * D * D, R, 2 * D, D}; pg8::StaticOrder S; S.init(R, 2 * D, F.G, (int)blockIdx.x);
                pg8::EpiGeluStats E{UVo, VSTAT};
                pg8::gemm_phase<pg8::EpiGeluStats, pg8::StaticOrder, true, true>(F.lds, g, S, E); }
            else { pg8::Gemm g{H, (const bf16*)(ws + WS_WQKV) + (size_t)j * NQKV * D, R, NQKV, D}; pg8::StaticOrder S; S.init(R, NQKV, F.G, (int)blockIdx.x);
                pg8::EpiQKV E{UVo, (const float*)(ws + WS_ROPE), (const float*)(ws + WS_ROPE) + 1024, 0.125f * LOG2E};
                pg8::gemm_phase<pg8::EpiQKV, pg8::StaticOrder, true, true>(F.lds, g, S, E); }
            SEAM(pb);
        }
        if (IN(pb + 1)) {
            if constexpr (!odd) { for (int u = F.vcu; u < (R / 128) * 16; u += F.G) sg_unit(F, u >> 4, u & 15, UV, VSTAT, a_vg + j * D, (const bf16*)(ws + WS_WS) + (size_t)j * 16 * 128 * 128, a_bs + j * 16 * 128, To); }
            else { const int NU = last ? 1024 : 1152;
                for (int u = F.vcu; u < NU; u += F.G) { if (u < 1024) att_unit(F, UV, b_sink + j * 32, To, u >> 8, (u >> 6) & 3, (u & 63) * 32, 0); else { const int v = u - 1024; att_unit(F, UV, b_sink + j * 32, To, v >> 5, (v >> 3) & 3, -1, (v & 7) * 32); } } }
            SEAM(pb + 1);
        }
        if (IN(pb + 2)) {
            pg8::Gemm g{T, (const bf16*)(ws + (odd ? WS_WO : WS_WOUT)) + (size_t)j * D * D, Mact, D, D}; pg8::StaticOrder S; S.init(Mact, D, F.G, (int)blockIdx.x);
            pg8::EpiF32 E{Yo, D};
            pg8::gemm_phase<pg8::EpiF32, pg8::StaticOrder, true, true>(F.lds, g, S, E);
            SEAM(pb + 2);
        }
        if (IN(pb + 3)) {
            for (int row = gw; row < Mact; row += NGW) { const int r = mod_index(row);
                const float* xs = l == 0 ? (row < RL ? x_in + (size_t)row * D : ctx_in + (size_t)(row - RL) * D) : XS + (size_t)row * D;
                thin_resid_row(F.lane, xs, Y + (size_t)row * D, MV(l, r, 2), XSo + (size_t)row * D, MV(l, r, 4), MV(l, r, 3), Ho + (size_t)row * D); }
            SEAM(pb + 3);
        }
        if (IN(pb + 4)) {
            pg8::Gemm g{H, (const bf16*)(ws + WS_WGU) + (size_t)l * 2 * FF * D, Mact, 2 * FF, D}; pg8::StaticOrder S; S.init(Mact, 2 * FF, F.G, (int)blockIdx.x);
            pg8::EpiSwiGLU E{ACTo};
            pg8::gemm_phase<pg8::EpiSwiGLU, pg8::StaticOrder, true, true>(F.lds, g, S, E);
            SEAM(pb + 4);
        }
        if (IN(pb + 5)) {
            pg8::Gemm g{ACT, (const bf16*)(ws + WS_WDN) + (size_t)l * D * FF, Mact, D, FF}; pg8::StaticOrder S; S.init(Mact, D, F.G, (int)blockIdx.x);
            pg8::EpiF32 E{Yo, D};
            pg8::gemm_phase<pg8::EpiF32, pg8::StaticOrder, true, true>(F.lds, g, S, E);
            SEAM(pb + 5);
        }
        if (IN(pb + 6)) {
            for (int row = gw; row < Mact; row += NGW) { const int r = mod_index(row); const int ln = last ? l : l + 1;
                thin_resid_row(F.lane, XS + (size_t)row * D, Y + (size_t)row * D, MV(l, r, 5), last ? OUTo + (size_t)row * D : XSo + (size_t)row * D, MV(ln, r, 1), MV(ln, r, 0), last ? (bf16*)nullptr : Ho + (size_t)row * D); }
            SEAM(pb + 6);
        }
    }
}
__global__ void __launch_bounds__(NWAVES * 64, 2) fwd(Args args) {
    extern __shared__ __attribute__((aligned(16))) unsigned char lds_raw[];
    Frame F;
    F.lds = (LAS unsigned char*)lds_raw;
    F.tid = threadIdx.x; F.lane = F.tid & 63; F.wave = __builtin_amdgcn_readfirstlane(F.tid >> 6);
    F.G = gridDim.x; { const int bx = blockIdx.x; F.vcu = (F.G % 8 == 0) ? (bx % 8) * (F.G / 8) + bx / 8 : bx; }
    unsigned char* ws = args.ws;
    volatile LAS unsigned* MISC = (volatile LAS unsigned*)(F.lds + MISC_OFF);
    for (int u = F.tid; u < (LDS_BYTES - MISC_OFF) / 4; u += NWAVES * 64) MISC[u] = 0u;
    __syncthreads();
    XcdBarrier bar = xcd_barrier_post((unsigned*)(ws + WS_CTL) + CW_BAR, MISC + 8);
    const int lo = args.ph_lo, hi = args.ph_hi;
    const float* x_in = args.in[0]; const float* ctx_in = args.in[2];
    bf16* H = (bf16*)(ws + WS_H); const float* MODV = (const float*)(ws + WS_MODV);
    const int gw = F.vcu * NWAVES + F.wave, NGW = F.G * NWAVES;

    if (IN(0)) {
        P0Args a{args.in[1], args.in[3], args.in[4], args.in[5], args.in[6], args.in[7], args.in[9], args.in[11], args.in[12], args.in[14], args.in[15], args.in[16], ws};
        p0_mod(F, a);
        __syncthreads();
        p0_convert(F, a);
        SEAM(0);
    }
    if (IN(1)) {
        for (int row = gw; row < R; row += NGW) { const int r = mod_index(row); const float* xr = row < RL ? x_in + (size_t)row * D : ctx_in + (size_t)(row - RL) * D;
            thin_norm_row(F.lane, xr, MV(0, r, 1), MV(0, r, 0), (args.altB ? (bf16*)args.altB : H) + (size_t)row * D); }
        SEAM(1);
    }
    layer<0>(F, args, bar, lo, hi);
    layer<1>(F, args, bar, lo, hi);
    layer<2>(F, args, bar, lo, hi);
    layer<3>(F, args, bar, lo, hi);
}
#undef IN
#undef SEAM
#undef MV

#ifndef MK_PER_PHASE
#define MK_PER_PHASE 0
#endif
extern "C" void kernel_launch(void* const* d_in, const int* in_sizes, int n_in, void* d_out, int out_size, void* d_ws, size_t ws_size, hipStream_t stream) {
    static int grid = 0;
    if (grid == 0) {
        if (n_in != 17 || ws_size < WS_END) { fprintf(stderr, "kernel_launch: need 17 inputs and %zu bytes of workspace (got %d, %zu)\n", (size_t)WS_END, n_in, ws_size); grid = -1; return; }
        int dev = 0, cus = 0, per_cu = 0;
        if (hipGetDevice(&dev) != hipSuccess || hipDeviceGetAttribute(&cus, hipDeviceAttributeMultiprocessorCount, dev) != hipSuccess) { grid = -1; return; }
        if (hipFuncSetAttribute((const void*)fwd, hipFuncAttributeMaxDynamicSharedMemorySize, LDS_BYTES) != hipSuccess) { fprintf(stderr, "kernel_launch: hipFuncSetAttribute failed\n"); grid = -1; return; }
        if (hipOccupancyMaxActiveBlocksPerMultiprocessor(&per_cu, (const void*)fwd, NWAVES * 64, LDS_BYTES) != hipSuccess || per_cu < 1) fprintf(stderr, "kernel_launch: occupancy query reports %d\n", per_cu);
        (void)hipGetLastError();
        grid = cus;
    }
    if (grid < 0) return;
    if (hipMemsetAsync((char*)d_ws + WS_CTL, 0, CTL_ZERO_BYTES, stream) != hipSuccess) return;
    Args a{};
    for (int i = 0; i < 17; ++i) a.in[i] = (const float*)d_in[i];
    a.out = (float*)d_out; a.ws = (unsigned char*)d_ws;
#if DEBUG_CHECK
    {
        using namespace dbg;
        const float* x = a.in[0]; const float* c = a.in[1]; const float* ctx = a.in[2]; const float* c_ctx = a.in[3]; const float* w_mod = a.in[4]; const float* b_mod = a.in[5]; const float* norm_g = a.in[6];
        const float* a_w_in = a.in[7]; const float* a_vg = a.in[8]; const float* a_w_s = a.in[9]; const float* a_b_s = a.in[10]; const float* a_w_out = a.in[11]; const float* b_w_qkv = a.in[12];
        const float* b_sink = a.in[13]; const float* b_w_o = a.in[14]; const float* f_w_gu = a.in[15]; const float* f_w_down = a.in[16];
        unsigned char* ws = (unsigned char*)d_ws; float* out = (float*)d_out;
        float* XS = (float*)(ws + WS_XS); bf16* H = (bf16*)(ws + WS_H); bf16* UV = (bf16*)(ws + WS_UV); bf16* T = (bf16*)(ws + WS_T); float* Y = (float*)(ws + WS_Y); bf16* ACT = (bf16*)(ws + WS_ACT);
        unsigned char* ALTA = ws + WS_END; unsigned char* ALTB = ALTA + 100 * MiB; float* MODR = (float*)(ALTB + 36 * MiB); float* STATS = MODR + DEPTH * 5 * NMOD * D; float* ERR = (float*)(ws + WS_CTL) + 131072;
        if (ws_size < WS_END + 140 * MiB) { fprintf(stderr, "debug: ws too small\n"); return; }
        (void)hipMemsetAsync(ws + CTL_ZERO_BYTES, 0xAA, WS_END + 140 * MiB - CTL_ZERO_BYTES, stream);
        auto phase = [&](int p, bool alt) { if (DEBUG_TRUTH_ONLY || p < DEBUG_PH_LO || p >= DEBUG_PH_HI) return; a.ph_lo = p; a.ph_hi = p + 1; a.altA = alt ? ALTA : nullptr; a.altB = alt ? ALTB : nullptr; hipLaunchKernelGGL(fwd, dim3(grid), dim3(NWAVES * 64), LDS_BYTES, stream, a); };
        auto cmpb = [&](const bf16* n, const bf16* t, int rows, int cols, int ld_, int id) { k_cmp<bf16><<<2048, 256, 0, stream>>>(n, t, rows, cols, ld_, ERR, id); };
        auto cmpf = [&](const float* n, const float* t, int rows, int cols, int ld_, int id) { k_cmp<float><<<2048, 256, 0, stream>>>(n, t, rows, cols, ld_, ERR, id); };
        phase(0, false);
        k_mod<<<DEPTH * 5 * NMOD * D / 256, 256, 0, stream>>>(c, c_ctx, w_mod, b_mod, MODR);
        k_concat<<<(size_t)R * D / 4 / 256, 256, 0, stream>>>(x, ctx, XS);
        phase(1, true);
        k_norm<<<R, 256, 0, stream>>>(XS, norm_g, MODR, 0, 1, H);
        cmpb((bf16*)ALTB, H, R, D, D, 1);
        for (int i = 0; i < DEPTH; ++i) {
            const bool last = i == DEPTH - 1, is_attn = (i & 1) == 1; const int j = i >> 1, pb = 2 + 7 * i, cb = 2 + 9 * i;
            const float* modl = MODR + (size_t)i * 5 * NMOD * D; const float* ng = norm_g + (size_t)i * 4 * D; const int Mact = last ? RL : R;
            phase(pb, true);
            if (!is_attn) { k_gemm<1, bf16><<<dim3(2 * D / 64, R / 64), 256, 0, stream>>>(H, a_w_in + (size_t)j * D * 2 * D, UV, R, 2 * D, D, 2 * D, 2 * D); cmpb((bf16*)ALTA, UV, R, 2 * D, 2 * D, cb); }
            else { k_gemm<0, bf16><<<dim3(NQKV / 64, R / 64), 256, 0, stream>>>(H, b_w_qkv + (size_t)j * D * NQKV, UV, R, NQKV, D, NQKV, NQKV); k_rope_scale<<<(size_t)R * 36 * 32 / 256, 256, 0, stream>>>(UV, 0.125f * LOG2E); cmpb((bf16*)ALTA, UV, R, NQKV, NQKV, cb); }
            phase(pb + 1, true);
            if (!is_attn) { k_lnstats<<<R, 256, 0, stream>>>(UV, STATS); k_cmp_stats<<<36, 256, 0, stream>>>((const float*)(ws + WS_VSTAT), STATS, R, ERR, 40 + i); k_sg<<<R, 256, 0, stream>>>(UV, STATS, a_vg + j * D, a_w_s + (size_t)j * 16 * 128 * 128, a_b_s + j * 16 * 128, T); }
            else k_attn<<<Mact * 32 / 64, 64, 0, stream>>>(UV, b_sink + j * 32, T, Mact);
            cmpb((bf16*)ALTB, T, Mact, D, D, cb + 1);
            if (i == 0) { k_cmp_wf<<<512, 256, 0, stream>>>((const bf16*)(ws + WS_WS), a_w_s, (size_t)2 * 16 * 128 * 128, ERR, 41); k_count_poison<<<512, 256, 0, stream>>>((const unsigned*)(ws + WS_VSTAT), (size_t)R * 64, (unsigned*)ERR + 2 * 45); }
            if (false) { for (int k = 0; k < 8; ++k) { k_cmp_part<<<2048, 256, 0, stream>>>((bf16*)ALTB, T, Mact, D, D, ERR, 50 + k, 0, k); k_cmp_part<<<2048, 256, 0, stream>>>((bf16*)ALTB, T, Mact, D, D, ERR, 60 + k, 1, k); } }
            phase(pb + 2, true);
            k_gemm<0, float><<<dim3(D / 64, Mact / 64), 256, 0, stream>>>(T, (is_attn ? b_w_o : a_w_out) + (size_t)j * D * D, Y, Mact, D, D, D, D);
            cmpf((float*)ALTA, Y, Mact, D, D, cb + 2);
            phase(pb + 3, true);
            k_resid<<<Mact, 256, 0, stream>>>(XS, Y, ng + 1 * D, modl, 2, XS);
            k_norm<<<Mact, 256, 0, stream>>>(XS, ng + 2 * D, modl, 3, 4, H);
            cmpf((float*)ALTA, XS, Mact, D, D, cb + 3); cmpb((bf16*)ALTB, H, Mact, D, D, cb + 4);
            phase(pb + 4, true);
            k_gemm<2, bf16><<<dim3(FF / 64, Mact / 64), 256, 0, stream>>>(H, f_w_gu + (size_t)i * D * 2 * FF, ACT, Mact, FF, D, 2 * FF, FF);
            cmpb((bf16*)ALTA, ACT, Mact, FF, FF, cb + 5);
            phase(pb + 5, true);
            k_gemm<0, float><<<dim3(D / 64, Mact / 64), 256, 0, stream>>>(ACT, f_w_down + (size_t)i * FF * D, Y, Mact, D, FF, D, D);
            cmpf((float*)ALTA, Y, Mact, D, D, cb + 6);
            phase(pb + 6, true);
            k_resid<<<Mact, 256, 0, stream>>>(XS, Y, ng + 3 * D, modl, 5, last ? out : XS);
            cmpf((float*)ALTA, last ? out : XS, Mact, D, D, cb + 7);
            if (!last) { k_norm<<<R, 256, 0, stream>>>(XS, norm_g + (size_t)(i + 1) * 4 * D, MODR + (size_t)(i + 1) * 5 * NMOD * D, 0, 1, H); cmpb((bf16*)ALTB, H, R, D, D, cb + 8); }
        }
        k_flag<<<1, 64, 0, stream>>>(ERR, 2 + 9 * DEPTH - 1, out);
    }
#elif MK_PER_PHASE
    for (int p = 0; p < NPHASE; ++p) { a.ph_lo = p; a.ph_hi = p + 1; hipLaunchKernelGGL(fwd, dim3(grid), dim3(NWAVES * 64), LDS_BYTES, stream, a); }
#else
    a.ph_lo = 0; a.ph_hi = NPHASE;
    hipLaunchKernelGGL(fwd, dim3(grid), dim3(NWAVES * 64), LDS_BYTES, stream, a);
#endif
}
```
